# Optimizing an MI355X kernel written in HIP

```python
import math
import jax, jax.numpy as jnp
from jax import lax
import numpy as np

D_MODEL = 1024
BATCH = 2
SEQ = 8192
DEPTH = 2

GRID_W = 64
CTX_LEN = 256
HEAD_DIM = 64
NA_HEADS = 4
NA_WIDTH = NA_HEADS * HEAD_DIM
WIN_H = 8
WIN_W = 16
NA_QB = WIN_W
NA_KBW = 2 * WIN_W
DIFF_HEADS = 4
DIFF_QK_WIDTH = 2 * DIFF_HEADS * HEAD_DIM
DIFF_WIDTH = DIFF_HEADS * 2 * HEAD_DIM
CONV_WIDTH = 256
CONV_K = 3
MIX_WIDTH = NA_WIDTH + DIFF_WIDTH + CONV_WIDTH
OFF_K = NA_WIDTH + DIFF_QK_WIDTH
OFF_V = OFF_K + NA_WIDTH + DIFF_QK_WIDTH
OFF_CONV = OFF_V + NA_WIDTH + DIFF_WIDTH
IN_COLS = OFF_CONV + 3 * CONV_WIDTH
SPLIT_IDX = (NA_WIDTH, OFF_K, OFF_K + NA_WIDTH, OFF_V, OFF_V + NA_WIDTH, OFF_CONV, OFF_CONV + CONV_WIDTH, OFF_CONV + 2 * CONV_WIDTH)
KV_SPLIT_IDX = (NA_WIDTH, NA_WIDTH + DIFF_QK_WIDTH, 2 * NA_WIDTH + DIFF_QK_WIDTH)
Q_BLOCK = 128
ROPE_BASE = 10000.0
D_FF = 2816
N_EXPERTS = 8
TOP_K = 2
D_EXPERT = 3584
N_DENSE = (DEPTH + 1) // 2
N_MOE = DEPTH // 2
EPS = 1e-6
NEG_INF = -1e30

kernel_name = 'hybrid_na_diffattn_shortconv_moe_dit'


def rms_norm(x, gain=None):
    xf = x.astype(jnp.float32)
    y = xf * lax.rsqrt(jnp.mean(jnp.square(xf), axis=-1, keepdims=True) + EPS)
    if gain is not None:
        y = y * gain.astype(jnp.float32)
    return y.astype(x.dtype)


def modulate(h, shift, scale):
    return h * (1 + scale) + shift


def axial_rope(n, dtype):
    t = jnp.arange(n, dtype=jnp.int32)
    row = (t // GRID_W).astype(jnp.float32)
    col = (t % GRID_W).astype(jnp.float32)
    n_freq = HEAD_DIM // 4
    inv_freq = ROPE_BASE ** (-jnp.arange(n_freq, dtype=jnp.float32) / n_freq)
    ang = jnp.concatenate([row[:, None] * inv_freq, col[:, None] * inv_freq], axis=-1)
    return jnp.cos(ang).astype(dtype), jnp.sin(ang).astype(dtype)


def apply_rope(x, cos, sin):
    half = HEAD_DIM // 2
    x1, x2 = x[..., :half], x[..., half:]
    c = cos[None, :, None, :]
    s = sin[None, :, None, :]
    return jnp.concatenate([x1 * c - x2 * s, x2 * c + x1 * s], axis=-1)


def ctx_softmax_attention(q, k, v):
    s = jnp.einsum('bqhd,bkhd->bhqk', q, k, preferred_element_type=jnp.float32) * HEAD_DIM ** -0.5
    p = jax.nn.softmax(s, axis=-1).astype(v.dtype)
    return jnp.einsum('bhqk,bkhd->bqhd', p, v)


def neighbourhood_attention(q, k, v, kc, vc, rpb):
    b, n = q.shape[:2]
    rows = n // GRID_W
    kh = min(WIN_H, rows)
    ncb = GRID_W // NA_QB
    r = jnp.arange(rows)
    j = jnp.arange(ncb)
    row_start = jnp.clip(r - kh // 2, 0, rows - kh)
    col_blk = jnp.clip(j * NA_QB - WIN_W // 2, 0, GRID_W - NA_KBW)
    key_rows = row_start[:, None] + jnp.arange(kh)[None, :]
    key_cols = col_blk[:, None] + jnp.arange(NA_KBW)[None, :]
    idx = key_rows[:, None, :, None] * GRID_W + key_cols[None, :, None, :]
    nk = kh * NA_KBW
    k_blk = jnp.take(k, idx.reshape(-1), axis=1).reshape(b, rows, ncb, nk, NA_HEADS, HEAD_DIM)
    v_blk = jnp.take(v, idx.reshape(-1), axis=1).reshape(b, rows, ncb, nk, NA_HEADS, HEAD_DIM)
    q_blk = q.reshape(b, rows, ncb, NA_QB, NA_HEADS, HEAD_DIM)
    q_cols = j[:, None] * NA_QB + jnp.arange(NA_QB)[None, :]
    win_start = jnp.clip(q_cols - WIN_W // 2, 0, GRID_W - WIN_W)
    kc_b = key_cols[:, None, :]
    valid = (kc_b >= win_start[:, :, None]) & (kc_b < win_start[:, :, None] + WIN_W)
    dcol_idx = jnp.clip(kc_b - q_cols[:, :, None] + WIN_W - 1, 0, 2 * WIN_W - 2)
    drow_idx = key_rows - r[:, None] + WIN_H - 1
    bias = rpb[:, drow_idx[:, None, None, :, None], dcol_idx[None, :, :, None, :]].astype(jnp.float32)
    bias = jnp.where(valid[None, None, :, :, None, :], bias, NEG_INF)
    bias = bias.transpose(1, 2, 0, 3, 4, 5).reshape(rows, ncb, NA_HEADS, NA_QB, nk)
    scale = HEAD_DIM ** -0.5
    s_lat = jnp.einsum('brjqhd,brjkhd->brjhqk', q_blk, k_blk, preferred_element_type=jnp.float32) * scale + bias
    s_ctx = jnp.einsum('brjqhd,bkhd->brjhqk', q_blk, kc, preferred_element_type=jnp.float32) * scale
    p = jax.nn.softmax(jnp.concatenate([s_lat, s_ctx], axis=-1), axis=-1).astype(v.dtype)
    out = (jnp.einsum('brjhqk,brjkhd->brjqhd', p[..., :nk], v_blk)
           + jnp.einsum('brjhqk,bkhd->brjqhd', p[..., nk:], vc))
    return out.reshape(b, n, NA_WIDTH)


def diff_attend(q, k, v, lam):
    s = jnp.einsum('bqhd,bkhd->bhqk', q, k, preferred_element_type=jnp.float32) * HEAD_DIM ** -0.5
    p = jax.nn.softmax(s, axis=-1)
    b, _, nq, nkeys = p.shape
    p = p.reshape(b, DIFF_HEADS, 2, nq, nkeys)
    a = (p[:, :, 0] - lam * p[:, :, 1]).astype(v.dtype)
    return jnp.einsum('bhqk,bkhd->bqhd', a, v)


def diff_latent(q, k_all, v_all, lam):
    b, n = q.shape[:2]
    qb = q.reshape(b, n // Q_BLOCK, Q_BLOCK, 2 * DIFF_HEADS, HEAD_DIM).transpose(1, 0, 2, 3, 4)
    out = lax.map(lambda blk: diff_attend(blk, k_all, v_all, lam), qb)
    return out.transpose(1, 0, 2, 3, 4).reshape(b, n, DIFF_HEADS, 2 * HEAD_DIM)


def diff_post(o, subln_gain, lambda_init):
    return rms_norm(o, subln_gain) * (1.0 - lambda_init)


def short_conv(u, w):
    n = u.shape[1]
    up = jnp.pad(u, ((0, 0), (CONV_K // 2, CONV_K // 2), (0, 0)))
    y = w[0] * up[:, 0:n]
    for t in range(1, CONV_K):
        y = y + w[t] * up[:, t:t + n]
    return y


def swiglu(h, w1, w3, w2):
    return (jax.nn.silu(h @ w1) * (h @ w3)) @ w2


def moe_ffn(h, w_router, w1, w3, w2):
    logits = jnp.einsum('...d,de->...e', h.astype(jnp.float32), w_router.astype(jnp.float32))
    top_vals, top_idx = lax.top_k(logits, TOP_K)
    top_w = jax.nn.softmax(top_vals, axis=-1)
    gates = jnp.sum(jax.nn.one_hot(top_idx, N_EXPERTS, dtype=jnp.float32) * top_w[..., None], axis=-2).astype(h.dtype)
    y = jnp.zeros_like(h)
    for e in range(N_EXPERTS):
        y = y + gates[..., e:e + 1] * swiglu(h, w1[e], w3[e], w2[e])
    return y


def token_mixer(h_lat, h_ctx, w_in, w_out, rpb, lam, lambda_init, subln_gain, conv_w, cos, sin, ctx_out):
    b, n, _ = h_lat.shape
    L = h_ctx.shape[1]
    qa, qb, ka, kb, va, vb, xin, bg, cg = jnp.split(h_lat @ w_in, SPLIT_IDX, axis=-1)
    qa = qa.reshape(b, n, NA_HEADS, HEAD_DIM)
    ka = ka.reshape(b, n, NA_HEADS, HEAD_DIM)
    va = va.reshape(b, n, NA_HEADS, HEAD_DIM)
    qb = apply_rope(qb.reshape(b, n, 2 * DIFF_HEADS, HEAD_DIM), cos, sin)
    kb = apply_rope(kb.reshape(b, n, 2 * DIFF_HEADS, HEAD_DIM), cos, sin)
    vb = vb.reshape(b, n, DIFF_HEADS, 2 * HEAD_DIM)
    ka_c, kb_c, va_c, vb_c = jnp.split(h_ctx @ w_in[:, OFF_K:OFF_CONV], KV_SPLIT_IDX, axis=-1)
    ka_c = ka_c.reshape(b, L, NA_HEADS, HEAD_DIM)
    va_c = va_c.reshape(b, L, NA_HEADS, HEAD_DIM)
    kb_c = kb_c.reshape(b, L, 2 * DIFF_HEADS, HEAD_DIM)
    vb_c = vb_c.reshape(b, L, DIFF_HEADS, 2 * HEAD_DIM)
    na = neighbourhood_attention(qa, ka, va, ka_c, va_c, rpb)
    k_all = jnp.concatenate([kb_c, kb], axis=1)
    v_all = jnp.concatenate([vb_c, vb], axis=1)
    dif = diff_post(diff_latent(qb, k_all, v_all, lam), subln_gain, lambda_init).reshape(b, n, DIFF_WIDTH)
    conv = bg * short_conv(cg * xin, conv_w)
    out_lat = jnp.concatenate([na, dif, conv], axis=-1) @ w_out
    if not ctx_out:
        return out_lat, None
    qa_c, qb_c = jnp.split(h_ctx @ w_in[:, :OFF_K], (NA_WIDTH,), axis=-1)
    xin_c, bg_c, cg_c = jnp.split(h_ctx @ w_in[:, OFF_CONV:], (CONV_WIDTH, 2 * CONV_WIDTH), axis=-1)
    na_c = ctx_softmax_attention(qa_c.reshape(b, L, NA_HEADS, HEAD_DIM), ka_c, va_c).reshape(b, L, NA_WIDTH)
    dif_c = diff_post(diff_attend(qb_c.reshape(b, L, 2 * DIFF_HEADS, HEAD_DIM), kb_c, vb_c, lam),
                      subln_gain, lambda_init).reshape(b, L, DIFF_WIDTH)
    conv_c = bg_c * short_conv(cg_c * xin_c, conv_w)
    out_ctx = jnp.concatenate([na_c, dif_c, conv_c], axis=-1) @ w_out
    return out_lat, out_ctx


def setup_inputs(seed: int = 0) -> dict:
    key = jax.random.key(seed)
    ks = jax.random.split(key, 20)
    f32 = jnp.float32

    def nrm(k, shape, scale):
        return jax.random.normal(k, shape, f32) * scale

    return {
        'x': nrm(ks[0], (BATCH, SEQ, D_MODEL), 1.0),
        'c': nrm(ks[1], (BATCH, D_MODEL), 1.0),
        'ctx': nrm(ks[2], (BATCH, CTX_LEN, D_MODEL), 1.0),
        'c_ctx': nrm(ks[3], (D_MODEL,), 1.0),
        'ada_w': nrm(ks[4], (DEPTH, D_MODEL, 6 * D_MODEL), 0.5 * D_MODEL ** -0.5),
        'ada_b': nrm(ks[5], (DEPTH, 6 * D_MODEL), 0.01),
        'w_in': nrm(ks[6], (DEPTH, D_MODEL, IN_COLS), D_MODEL ** -0.5),
        'w_out': nrm(ks[7], (DEPTH, MIX_WIDTH, D_MODEL), MIX_WIDTH ** -0.5),
        'na_rpb': nrm(ks[8], (DEPTH, NA_HEADS, 2 * WIN_H - 1, 2 * WIN_W - 1), 0.1),
        'diff_lambda': nrm(ks[9], (DEPTH, 4, HEAD_DIM), 0.1),
        'diff_subln': 1.0 + nrm(ks[10], (DEPTH, 2 * HEAD_DIM), 0.02),
        'conv_w': nrm(ks[11], (DEPTH, CONV_K, CONV_WIDTH), CONV_K ** -0.5),
        'ffn_w1': nrm(ks[12], (N_DENSE, D_MODEL, D_FF), D_MODEL ** -0.5),
        'ffn_w3': nrm(ks[13], (N_DENSE, D_MODEL, D_FF), D_MODEL ** -0.5),
        'ffn_w2': nrm(ks[14], (N_DENSE, D_FF, D_MODEL), D_FF ** -0.5),
        'router_w': nrm(ks[15], (N_MOE, D_MODEL, N_EXPERTS), D_MODEL ** -0.5),
        'moe_w1': nrm(ks[16], (N_MOE, N_EXPERTS, D_MODEL, D_EXPERT), D_MODEL ** -0.5),
        'moe_w3': nrm(ks[17], (N_MOE, N_EXPERTS, D_MODEL, D_EXPERT), D_MODEL ** -0.5),
        'moe_w2': nrm(ks[18], (N_MOE, N_EXPERTS, D_EXPERT, D_MODEL), D_EXPERT ** -0.5),
        'final_gain': 1.0 + nrm(ks[19], (D_MODEL,), 0.02),
    }


def reference(x, c, ctx, c_ctx, ada_w, ada_b, w_in, w_out, na_rpb, diff_lambda, diff_subln, conv_w,
              ffn_w1, ffn_w3, ffn_w2, router_w, moe_w1, moe_w3, moe_w2, final_gain):
    n = x.shape[1]
    cos, sin = axial_rope(n, x.dtype)
    x_lat, x_ctx = x, ctx
    for i in range(DEPTH):
        ctx_out = i < DEPTH - 1
        mod_lat = (jax.nn.silu(c) @ ada_w[i] + ada_b[i])[:, None, :]
        mod_ctx = jax.nn.silu(c_ctx) @ ada_w[i] + ada_b[i]
        sh_a, sc_a, g_a, sh_f, sc_f, g_f = jnp.split(mod_lat, 6, axis=-1)
        csh_a, csc_a, cg_a, csh_f, csc_f, cg_f = jnp.split(mod_ctx, 6, axis=-1)
        lq1, lk1, lq2, lk2 = [t.astype(jnp.float32) for t in diff_lambda[i]]
        lambda_init = 0.8 - 0.6 * math.exp(-0.3 * i)
        lam = jnp.exp(jnp.sum(lq1 * lk1)) - jnp.exp(jnp.sum(lq2 * lk2)) + lambda_init
        h_lat = modulate(rms_norm(x_lat), sh_a, sc_a)
        h_ctx = modulate(rms_norm(x_ctx), csh_a, csc_a)
        out_lat, out_ctx = token_mixer(h_lat, h_ctx, w_in[i], w_out[i], na_rpb[i], lam, lambda_init,
                                       diff_subln[i], conv_w[i], cos, sin, ctx_out)
        x_lat = x_lat + g_a * out_lat
        if i % 2 == 0:
            m = i // 2
            ffn = functools_partial_swiglu(ffn_w1[m], ffn_w3[m], ffn_w2[m])
        else:
            m = i // 2
            ffn = functools_partial_moe(router_w[m], moe_w1[m], moe_w3[m], moe_w2[m])
        x_lat = x_lat + g_f * ffn(modulate(rms_norm(x_lat), sh_f, sc_f))
        if ctx_out:
            x_ctx = x_ctx + cg_a * out_ctx
            x_ctx = x_ctx + cg_f * ffn(modulate(rms_norm(x_ctx), csh_f, csc_f))
    return rms_norm(x_lat, final_gain)


def functools_partial_swiglu(w1, w3, w2):
    return lambda h: swiglu(h, w1, w3, w2)


def functools_partial_moe(w_router, w1, w3, w2):
    return lambda h: moe_ffn(h, w_router, w1, w3, w2)
```

```cpp
#include <hip/hip_runtime.h>
#include <cstdio>
#include <cstdint>

#define LAS __attribute__((address_space(3)))
#define GAS __attribute__((address_space(1)))
typedef unsigned short bf16_t;
typedef short bf16x8 __attribute__((ext_vector_type(8)));
typedef short s16x4 __attribute__((ext_vector_type(4)));
typedef float f32x2 __attribute__((ext_vector_type(2)));
typedef float f32x4 __attribute__((ext_vector_type(4)));
typedef float f32x16 __attribute__((ext_vector_type(16)));
typedef unsigned u32x2 __attribute__((ext_vector_type(2)));
typedef unsigned u32x4 __attribute__((ext_vector_type(4)));
typedef GAS unsigned gu32;
typedef __bf16 bf16x2_t __attribute__((ext_vector_type(2)));

#ifndef MK_N_LAUNCHES
#define MK_N_LAUNCHES 1
#endif

constexpr int D = 1024, BATCH = 2, SEQ = 8192, NLAT = BATCH * SEQ, CTXL = 256, NCTX = BATCH * CTXL, MROWS = NLAT + NCTX;
constexpr int GRIDW = 64, GROWS = SEQ / GRIDW;
constexpr int INC = 3072, DFF = 2816, DEXP = 3584, NEXP = 8;
constexpr int KVR = CTXL + SEQ;
constexpr int QKVROWS = BATCH * KVR;
constexpr int C_QA = 0, C_QB = 256, C_KA = 768, C_KB = 1024, C_VA = 1536, C_VB = 1792, C_XIN = 2304, C_BG = 2560, C_CG = 2816;
constexpr float EPS = 1e-6f;
constexpr float LOG2E = 1.4426950408889634f;
constexpr float C2 = 0.125f * LOG2E;
constexpr int MOE_MAXP = 136;

constexpr size_t MiB = 1u << 20;
constexpr size_t WS_CTL = 0, CTL_ZERO_BYTES = 1 * MiB;
constexpr size_t WS_MODS = 1 * MiB;
constexpr size_t WS_TABR = WS_MODS + 2 * 3 * 6144 * 4;
constexpr size_t WS_TABC = WS_TABR + 128 * 16 * 8;
constexpr size_t WS_LAM = WS_TABC + 64 * 16 * 8;
constexpr size_t WS_TOKL = 2 * MiB;
constexpr size_t WS_GATL = WS_TOKL + 8 * 16384 * 4;
constexpr size_t WS_TINFO = 3 * MiB;
constexpr size_t WS_XCTX = 4 * MiB;
constexpr size_t WS_MW2 = 6 * MiB;
constexpr size_t WS_MW13 = 62 * MiB;
constexpr size_t WS_H = 174 * MiB;
constexpr size_t WS_Y = 62 * MiB;
constexpr size_t WS_ARENA = 207 * MiB;
constexpr size_t WS_WIN = WS_ARENA;
constexpr size_t WS_WOUT = WS_WIN + 12 * MiB;
constexpr size_t WS_W13 = WS_WOUT + 4 * MiB;
constexpr size_t WS_W2 = WS_W13 + 11 * MiB;
constexpr size_t WS_QKV = WS_W2 + 6 * MiB;
constexpr size_t WS_CAT = WS_QKV + 99 * MiB;
constexpr size_t WS_HID = WS_CAT + 33 * MiB;
constexpr size_t WS_MHID = WS_ARENA;
constexpr size_t WS_YT = WS_ARENA + 238 * MiB;
constexpr size_t WS_END = WS_YT + 28 * MiB;
static_assert(WS_YT >= WS_MHID + (size_t)MOE_MAXP * 256 * DEXP * 2, "tail partials behind the MoE hidden buffer");
static_assert(WS_Y + (size_t)MOE_MAXP * 256 * D * 4 <= WS_ARENA, "Y overlay");
static_assert(WS_MHID + (size_t)MOE_MAXP * 256 * DEXP * 2 <= WS_END, "MoE hidden overlay");
static_assert(WS_TINFO + (size_t)NLAT * 32 <= WS_XCTX && WS_LAM + 64 <= WS_TOKL, "map");
constexpr int CW_TMO = 0, CW_CODE = 1, CW_BAR = 4096, CW_ECNT = 16384;

constexpr int RING_BYTES = 131072;
constexpr int MISC_OFF = RING_BYTES + 320;
constexpr int LDS_BYTES = 147456;
constexpr int NWAVES = 8;

__device__ __forceinline__ unsigned cvt_pk_bf16(float lo, float hi) { unsigned r; asm volatile("v_cvt_pk_bf16_f32 %0, %1, %2" : "=v"(r) : "v"(lo), "v"(hi)); return r; }
__device__ __forceinline__ unsigned pk_fp8x4(float a, float b, float c, float d) { int w = 0; w = __builtin_amdgcn_cvt_pk_fp8_f32(a, b, w, false); w = __builtin_amdgcn_cvt_pk_fp8_f32(c, d, w, true); return (unsigned)w; }
constexpr float MOE_W13_SCALE = 32.f, MOE_W2_SCALE = 64.f;
__device__ __forceinline__ float bf2f(unsigned short b) { return __builtin_bit_cast(float, (unsigned)b << 16); }
__device__ __forceinline__ float wave_sum(float v) {
#pragma unroll
    for (int o = 1; o < 64; o <<= 1) v += __shfl_xor(v, o);
    return v;
}
__device__ __forceinline__ int fresh_tid() { int t = threadIdx.x; asm volatile("" : "+v"(t)); return t; }
__device__ __forceinline__ void st16_wt(void* p, u32x4 v) { asm volatile("global_store_dwordx4 %0, %1, off sc0 sc1\n\ts_nop 1" :: "v"(p), "v"(v) : "memory"); }
__device__ __forceinline__ void st8_wt(void* p, u32x2 v) { asm volatile("global_store_dwordx2 %0, %1, off sc0 sc1\n\ts_nop 1" :: "v"(p), "v"(v) : "memory"); }
#define LDS_WAIT() asm volatile("s_waitcnt lgkmcnt(0)" ::: "memory")
#define VM_WAIT() asm volatile("s_waitcnt vmcnt(0)" ::: "memory")
#define RLX_AGENT __ATOMIC_RELAXED, __HIP_MEMORY_SCOPE_AGENT

namespace pg8 {
constexpr int BM = 256, BK = 64, HALF = 128, HTB = HALF * BK * 2, STAGE_BYTES = 8 * HTB, NXCD = 8, WGM = 8;
__host__ __device__ __forceinline__ int lds_byte(int r, int c) { const int st = (r >> 4) * 2 + (c >> 5), rr = r & 15, cc = c & 31, ob = rr * 64 + cc * 2; return st * 1024 + (ob ^ (((ob >> 9) & 1) << 5)); }
__host__ __device__ __forceinline__ void stage_rc(int b, int& R, int& C) { const int st = b / 1024, sb = b % 1024, swz = sb ^ (((sb >> 9) & 1) << 5); R = (st >> 1) * 16 + swz / 64; C = (st & 1) * 32 + (swz % 64) / 2; }
__host__ __device__ __forceinline__ int perm32(int rho) { const int n = rho >> 4, i = rho & 15; return 8 * (i >> 2) + 4 * n + (i & 3); }

struct Unit { int pm, pn, e, pl; };

struct TileOrder {
    int nM, nN, nwg, G, c;
    __device__ __forceinline__ void init(int nM_, int nN_, int G_, int c_) { nM = nM_; nN = nN_; nwg = nM * nN; G = G_; c = c_; }
    __device__ __forceinline__ bool tile(int i, int& pm, int& pn) const {
        const long L = (long)i * G + c; if (L >= nwg) return false;
        int wgid = (int)L; { const int q = nwg / NXCD, r = nwg % NXCD, xcd = wgid % NXCD, off = wgid / NXCD; wgid = (xcd < r ? xcd * (q + 1) : r * (q + 1) + (xcd - r) * q) + off; }
        const int nig = WGM * nN, gid = wgid / nig, fm = gid * WGM, gsz = (nM - fm) < WGM ? (nM - fm) : WGM;
        pm = fm + ((wgid % nig) % gsz); pn = (wgid % nig) / gsz; return true;
    }
};

template <class Epi, class Sched, bool ALIGN_EPI, bool F8 = false>
__device__ __forceinline__ void gemm_phase(LAS unsigned char* lds, const char* Abase, const int K, const Sched& S, const Epi& E, const int Klen = 0) {
    const int tid = fresh_tid(), wid = __builtin_amdgcn_readfirstlane(tid >> 6), lane = tid & 63, wr = wid >> 2, wc = wid & 3, fr = lane & 15, fq = lane >> 4;
    const int nt = (Klen ? Klen : K) / BK;
    int Rr[2], Cc[2]; unsigned voffB[2];
#pragma unroll
    for (int i = 0; i < 2; ++i) { int R, C; stage_rc(tid * 16 + i * 8192, R, C); const int Rb = Epi::PERM ? ((R & ~31) + perm32(R & 31)) : R; Rr[i] = R; Cc[i] = C; voffB[i] = (unsigned)(Rb * K + C) * 2u; }
    const size_t kstep = (size_t)(BK * 2);
    const size_t hstep = (size_t)HALF * K * 2;
    const unsigned ldsw = (unsigned)wid * 1024u;
    const int aoff = lds_byte(wr * 64 + fr, fq * 8), boff = lds_byte(wc * 32 + fr, fq * 8);
#define PG8_SA(b, h) (((b) * 2 + (h)) * HTB)
#define PG8_SB(b, h) ((4 + (b) * 2 + (h)) * HTB)
#define PG8_STAGE(bufoff, gbase, voff) do { _Pragma("unroll") for (int _i = 0; _i < 2; ++_i) \
        __builtin_amdgcn_global_load_lds((const unsigned*)((const char*)(gbase) + (voff)[_i]), (LAS unsigned*)(lds + (bufoff) + ldsw + _i * 8192), 16, 0, 0); } while (0)
    typedef int v4i_ __attribute__((ext_vector_type(4))); typedef int v8i_ __attribute__((ext_vector_type(8)));
#define PG8_LDA(dst, b, h) do { _Pragma("unroll") for (int m = 0; m < 4; ++m) { if constexpr (F8) { dst##8[m] = __builtin_shufflevector(*(const LAS v4i_*)(lds + PG8_SA(b, h) + aoff + m * 2048), *(const LAS v4i_*)(lds + PG8_SA(b, h) + aoff + m * 2048 + 1024), 0, 1, 2, 3, 4, 5, 6, 7); } \
        else { _Pragma("unroll") for (int k = 0; k < 2; ++k) dst[m][k] = *(const LAS bf16x8*)(lds + PG8_SA(b, h) + aoff + m * 2048 + k * 1024); } } } while (0)
#define PG8_LDB(dst, b, h) do { _Pragma("unroll") for (int n = 0; n < 2; ++n) { if constexpr (F8) { dst##8[n] = __builtin_shufflevector(*(const LAS v4i_*)(lds + PG8_SB(b, h) + boff + n * 2048), *(const LAS v4i_*)(lds + PG8_SB(b, h) + boff + n * 2048 + 1024), 0, 1, 2, 3, 4, 5, 6, 7); } \
        else { _Pragma("unroll") for (int k = 0; k < 2; ++k) dst[n][k] = *(const LAS bf16x8*)(lds + PG8_SB(b, h) + boff + n * 2048 + k * 1024); } } } while (0)
#define PG8_MMA(ai, bj, At, Bt) do { __builtin_amdgcn_s_setprio(1); _Pragma("unroll") for (int m = 0; m < 4; ++m) _Pragma("unroll") for (int n = 0; n < 2; ++n) { \
          \
        if constexpr (F8) asm("v_mfma_f32_16x16x128_f8f6f4 %0, %1, %2, %0" : "+v"(acc[ai][bj][m][n]) : "v"(Bt##8[n]), "v"(At##8[m]));   \
        else { _Pragma("unroll") for (int k = 0; k < 2; ++k) acc[ai][bj][m][n] = __builtin_amdgcn_mfma_f32_16x16x32_bf16(Bt[n][k], At[m][k], acc[ai][bj][m][n], 0, 0, 0); } } \
        __builtin_amdgcn_s_setprio(0); } while (0)
#define PG8_WAIT_V(n) asm volatile("s_waitcnt vmcnt(" #n ")" ::: "memory")
#define PG8_WAIT_L(n) asm volatile("s_waitcnt lgkmcnt(" #n ")" ::: "memory")
#define PG8_BAR __builtin_amdgcn_s_barrier()
#define PG8_SCHED __builtin_amdgcn_sched_barrier(0)
    Unit cur, nxt; int ui = 0;
    if (!S.next(0, cur)) return;
    f32x4 acc[2][2][4][2];
#pragma unroll
    for (int a = 0; a < 2; ++a)
#pragma unroll
        for (int b = 0; b < 2; ++b)
#pragma unroll
            for (int m = 0; m < 4; ++m)
#pragma unroll
                for (int n = 0; n < 2; ++n) acc[a][b][m][n] = (f32x4){0.f, 0.f, 0.f, 0.f};
    bf16x8 At[4][2], B0[2][2], B1[2][2]; v8i_ At8[4], B08[2], B18[2];
    constexpr bool GATHER = Sched::GATHER;
    unsigned voffA[2]; unsigned cv[2][2], nv[2][2];
#pragma unroll
    for (int i = 0; i < 2; ++i) voffA[i] = (unsigned)(Rr[i] * K + Cc[i]) * 2u;
    const char* cA = Abase; const char* nA = Abase;
    if constexpr (GATHER) S.a_offs(cur, Rr, Cc, cv); else cA = Abase + S.a_tile(cur);
    const char* cB = S.b_tile(cur);
#define PG8_STAGE_A(bufoff, h, kb, NX) do { if constexpr (GATHER) { const unsigned _v[2] = {(NX) ? nv[h][0] : cv[h][0], (NX) ? nv[h][1] : cv[h][1]}; PG8_STAGE(bufoff, Abase + (kb), _v); } \
        else { PG8_STAGE(bufoff, ((NX) ? nA : cA) + (h) * hstep + (kb), voffA); } } while (0)
    PG8_STAGE(PG8_SB(0, 0), cB, voffB); PG8_STAGE(PG8_SB(0, 1), cB + hstep, voffB); PG8_STAGE_A(PG8_SA(0, 0), 0, 0, false); PG8_STAGE_A(PG8_SA(0, 1), 1, 0, false);
    if (wr == 1) PG8_BAR;
    PG8_WAIT_V(2); PG8_BAR;
    PG8_STAGE(PG8_SB(1, 0), cB + kstep, voffB); PG8_STAGE_A(PG8_SA(1, 0), 0, kstep, false); PG8_STAGE(PG8_SB(1, 1), cB + hstep + kstep, voffB);
    PG8_WAIT_V(6); PG8_BAR;
    for (;;) {
        const bool has_next = S.next(ui + 1, nxt);
        const char* nB = cB; nA = cA;
        if (has_next) { if constexpr (GATHER) S.a_offs(nxt, Rr, Cc, nv); else nA = Abase + S.a_tile(nxt); nB = S.b_tile(nxt); }
        else { if constexpr (GATHER) {
#pragma unroll
            for (int h = 0; h < 2; ++h)
#pragma unroll
                for (int i = 0; i < 2; ++i) nv[h][i] = cv[h][i]; } }
#pragma unroll 1
        for (int t = 0; t < nt; t += 2) {
            const bool last = (t == nt - 2);
            const size_t k1 = (size_t)(t + 1) * kstep, k2 = last ? (size_t)0 : (size_t)(t + 2) * kstep, k3 = k2 + kstep;
            const char* b2 = last ? nB : cB + (size_t)(t + 2) * kstep; const char* b3 = b2 + kstep;
            PG8_LDB(B0, 0, 0); PG8_LDB(B1, 0, 1); PG8_SCHED; PG8_LDA(At, 0, 0); PG8_STAGE_A(PG8_SA(1, 1), 1, k1, false);
            PG8_WAIT_V(8); PG8_WAIT_L(0); PG8_BAR; PG8_MMA(0, 0, At, B0); PG8_MMA(0, 1, At, B1); PG8_BAR; PG8_SCHED;
            PG8_LDA(At, 0, 1); PG8_STAGE(PG8_SB(0, 0), b2, voffB); PG8_STAGE(PG8_SB(0, 1), b2 + hstep, voffB); PG8_STAGE_A(PG8_SA(0, 0), 0, k2, last);
            PG8_WAIT_V(8); PG8_WAIT_L(0); PG8_BAR; PG8_MMA(1, 0, At, B0); PG8_MMA(1, 1, At, B1); PG8_BAR; PG8_SCHED;
            PG8_LDB(B0, 1, 0); PG8_LDB(B1, 1, 1); PG8_SCHED; PG8_LDA(At, 1, 0); PG8_STAGE_A(PG8_SA(0, 1), 1, k2, last);
            PG8_WAIT_V(8); PG8_WAIT_L(0); PG8_BAR; PG8_MMA(0, 0, At, B0); PG8_MMA(0, 1, At, B1); PG8_BAR; PG8_SCHED;
            PG8_LDA(At, 1, 1); PG8_STAGE(PG8_SB(1, 0), b3, voffB); PG8_STAGE(PG8_SB(1, 1), b3 + hstep, voffB); PG8_STAGE_A(PG8_SA(1, 0), 0, k3, last);
            PG8_WAIT_V(8); PG8_WAIT_L(0); PG8_BAR; PG8_MMA(1, 0, At, B0); PG8_MMA(1, 1, At, B1); PG8_BAR; PG8_SCHED;
        }
        if constexpr (ALIGN_EPI) { if (wr == 0) PG8_BAR; }
        if constexpr (F8) asm volatile("s_nop 15\n\ts_nop 15" ::: "memory");
        E(acc, cur, wr, wc, fr, fq);
        if (!has_next) break;
#pragma unroll
        for (int a = 0; a < 2; ++a)
#pragma unroll
            for (int b = 0; b < 2; ++b)
#pragma unroll
                for (int m = 0; m < 4; ++m)
#pragma unroll
                    for (int n = 0; n < 2; ++n) acc[a][b][m][n] = (f32x4){0.f, 0.f, 0.f, 0.f};
        cur = nxt; cB = nB; cA = nA; ++ui;
        if constexpr (GATHER) {
#pragma unroll
            for (int h = 0; h < 2; ++h)
#pragma unroll
                for (int i = 0; i < 2; ++i) cv[h][i] = nv[h][i]; }
        if constexpr (ALIGN_EPI) { if (wr == 1) PG8_BAR; }
    }
    PG8_WAIT_V(0);
    if constexpr (!ALIGN_EPI) { if (wr == 0) PG8_BAR; }
    PG8_BAR;
#undef PG8_SA
#undef PG8_SB
#undef PG8_STAGE
#undef PG8_STAGE_A
#undef PG8_LDA
#undef PG8_LDB
#undef PG8_MMA
#undef PG8_WAIT_V
#undef PG8_WAIT_L
#undef PG8_BAR
#undef PG8_SCHED
}
}

#define XB_TMO      128
#define XB_XCNT(j)  (256  + 64 * (j))
#define XB_XSUB(j)  (1280 + 64 * (j))
#define XB_XGEN(j)  (2304 + 64 * (j))
#define XB_TOP      3328
#define XB_TOPGEN   3392
#define XCD_BAR_WORDS 3456
#define XB_SPIN_CAP (1u << 18)
__device__ __forceinline__ unsigned xb_ld(unsigned* p)              { return __hip_atomic_load(p, __ATOMIC_RELAXED, __HIP_MEMORY_SCOPE_AGENT); }
__device__ __forceinline__ unsigned xb_add(unsigned* p, unsigned v) { return __hip_atomic_fetch_add(p, v, __ATOMIC_RELAXED, __HIP_MEMORY_SCOPE_AGENT); }
__device__ __forceinline__ unsigned xb_xcc_id() { return (unsigned)__builtin_amdgcn_s_getreg((3 << 11) | 20) & 0xFu; }
#define XB_SPIN(cond, bar) do { unsigned _sp = 0; while (cond) { __builtin_amdgcn_s_sleep(1); \
    if ((++_sp & 255u) == 0u) { if (xb_ld(&(bar)[XB_TMO])) break; if (_sp > XB_SPIN_CAP) { atomicAdd(&(bar)[XB_TMO], 1u); break; } } } } while (0)
struct XcdBarrier { unsigned* bar; unsigned x; volatile LAS unsigned* st; };
__device__ __forceinline__ XcdBarrier xcd_barrier_post(unsigned* bar, volatile LAS unsigned* st) {
    XcdBarrier b; b.bar = bar; b.x = xb_xcc_id(); b.st = st;
    if (threadIdx.x == 0) (void)xb_add(&bar[XB_XCNT(b.x)], 1u);
    return b;
}
__device__ __forceinline__ void xcd_barrier_complete(unsigned* bar, unsigned x, unsigned& nloc, unsigned& nx) {
    const unsigned G = gridDim.x * gridDim.y * gridDim.z;
    unsigned sum, cnt, mine, sp = 0u;
    for (;;) {
        sum = 0u; cnt = 0u; mine = 0u;
#pragma unroll
        for (unsigned j = 0; j < 16; ++j) { const unsigned c = xb_ld(&bar[XB_XCNT(j)]); sum += c; cnt += (c > 0u) ? 1u : 0u; mine = (j == x) ? c : mine; }
        if (sum == G) break;
        __builtin_amdgcn_s_sleep(1);
        if ((++sp & 255u) == 0u) { if (xb_ld(&bar[XB_TMO])) break; if (sp > XB_SPIN_CAP) { atomicAdd(&bar[XB_TMO], 1u); break; } }
    }
    nloc = mine > 0u ? mine : 1u; nx = cnt > 0u ? cnt : 1u;
}
__device__ __forceinline__ void xcd_barrier(const XcdBarrier& b) {
    asm volatile("s_waitcnt vmcnt(0)" ::: "memory");
    __syncthreads();
    if (threadIdx.x == 0) {
        unsigned* bar = b.bar;
        __builtin_amdgcn_s_waitcnt(0);
        unsigned nloc = b.st[0], nx = b.st[1];
        if (nloc == 0u) { xcd_barrier_complete(bar, b.x, nloc, nx); b.st[0] = nloc; b.st[1] = nx; }
        const unsigned old = xb_add(&bar[XB_XSUB(b.x)], 1u);
        const unsigned gen = old / nloc;
        if (old + 1u == (gen + 1u) * nloc) {
            __builtin_amdgcn_fence(__ATOMIC_RELEASE, "agent");
            asm volatile("s_waitcnt vmcnt(0)" ::: "memory");
            const unsigned og = xb_add(&bar[XB_TOP], 1u);
            const unsigned tg = og / nx;
            if (og + 1u == (tg + 1u) * nx) xb_add(&bar[XB_TOPGEN], 1u);
            else XB_SPIN(xb_ld(&bar[XB_TOPGEN]) == tg, bar);
            __builtin_amdgcn_fence(__ATOMIC_ACQUIRE, "agent");
            xb_add(&bar[XB_XGEN(b.x)], 1u);
            asm volatile("s_waitcnt vmcnt(0)" ::: "memory");
        } else {
            XB_SPIN(xb_ld(&bar[XB_XGEN(b.x)]) == gen, bar);
            __builtin_amdgcn_fence(__ATOMIC_ACQUIRE, "agent");
            asm volatile("s_waitcnt vmcnt(0)" ::: "memory");
        }
    }
    __syncthreads();
}

struct Params {
    const float *x, *c, *ctx, *c_ctx, *ada_w, *ada_b, *w_in, *w_out, *na_rpb, *diff_lambda, *diff_subln, *conv_w,
                *ffn_w1, *ffn_w3, *ffn_w2, *router_w, *moe_w1, *moe_w3, *moe_w2, *final_gain;
    float* out; unsigned char* ws;
    int ph_lo, ph_hi, li, pad;
};
struct Ctx {
    LAS unsigned char* lds; char* ldsg;
    volatile LAS unsigned* MISC;
    gu32* ctl;
    int tid, lane, wave, vcu, G;
    unsigned char* ws;
};
__device__ __forceinline__ Ctx fresh(const Ctx& X0) { Ctx X = X0; X.tid = fresh_tid(); X.lane = X.tid & 63; X.wave = __builtin_amdgcn_readfirstlane(X.tid >> 6); return X; }
__device__ __forceinline__ const float* modp(const Ctx& X, int layer, int v, int idx) { return (const float*)(X.ws + WS_MODS) + ((size_t)(layer * 3 + v) * 6 + idx) * D; }

struct SchedPlain {
    static constexpr bool GATHER = false;
    pg8::TileOrder T; const char* Bt; int K;
    __device__ __forceinline__ bool next(int i, pg8::Unit& u) const { u.e = 0; const bool ok = T.tile(i, u.pm, u.pn); u.pl = u.pm; return ok; }
    __device__ __forceinline__ size_t a_tile(const pg8::Unit& u) const { return (size_t)u.pm * 256 * K * 2; }
    __device__ __forceinline__ void a_offs(const pg8::Unit&, const int (&)[2], const int (&)[2], unsigned (&)[2][2]) const {}
    __device__ __forceinline__ const char* b_tile(const pg8::Unit& u) const { return Bt + (size_t)u.pn * 256 * K * 2; }
};
template <bool GATHER_> struct SchedMoe {
    static constexpr bool GATHER = GATHER_;
    pg8::TileOrder T; const char* Bt; int K; size_t estride; volatile LAS unsigned* M; const int* tokl;
    __device__ __forceinline__ bool next(int i, pg8::Unit& u) const {
        const bool ok = T.tile(i, u.pm, u.pn); if (!ok) return false;
        int e = 0;
#pragma unroll
        for (int k = 1; k < NEXP; ++k) e += ((int)M[16 + k] <= u.pm) ? 1 : 0;
        u.e = __builtin_amdgcn_readfirstlane(e); u.pl = u.pm - (int)M[16 + u.e]; return true;
    }
    __device__ __forceinline__ size_t a_tile(const pg8::Unit& u) const { return (size_t)u.pm * 256 * K * 2; }
    __device__ __forceinline__ void a_offs(const pg8::Unit& u, const int (&R)[2], const int (&C)[2], unsigned (&v)[2][2]) const {
        const int cnt = (int)M[32 + u.e];
#pragma unroll
        for (int h = 0; h < 2; ++h)
#pragma unroll
            for (int i = 0; i < 2; ++i) { const int idx = u.pl * 256 + h * 128 + R[i]; const int tok = idx < cnt ? tokl[u.e * 16384 + idx] : 0; v[h][i] = (unsigned)(tok * K + C[i]) * 2u; }
    }
    __device__ __forceinline__ const char* b_tile(const pg8::Unit& u) const { return Bt + (size_t)u.e * estride + (size_t)u.pn * 256 * K * 2; }
};

struct EpiInProj {
    static constexpr bool PERM = true;
    bf16_t* QKV; const f32x2* tabR; const f32x2* tabC;
    __device__ __forceinline__ void operator()(const f32x4 (&acc)[2][2][4][2], const pg8::Unit& u, int wr, int wc, int fr, int fq) const {
        const int pm = u.pm, pn = u.pn; const bool isctx = pm >= 64;
        const int opanel = isctx ? (pm - 64) * 33 : (pm + 1 + (pm >= 32 ? 1 : 0));
        const int orow0 = opanel * 256 + wr * 64 + fr, arow0 = pm * 256 + wr * 64 + fr;
        const int col0 = pn * 256 + wc * 32 + 8 * fq;
        const bool rope = !isctx && (pn == 1 || pn == 2 || pn == 4 || pn == 5);
        const float sc = (pn <= 2) ? C2 : 1.f;
#pragma unroll
        for (int ai = 0; ai < 2; ++ai)
#pragma unroll
            for (int m = 0; m < 4; ++m) {
                const int t = (arow0 + ai * 128 + m * 16) & (SEQ - 1);
                f32x4 cs0 = (f32x4){1.f, 0.f, 1.f, 0.f}, cs1 = cs0;
                if (rope) { const f32x4* tb = (const f32x4*)(((wc & 1) ? tabC + (t & 63) * 16 : tabR + (t >> 6) * 16) + 4 * fq); cs0 = tb[0]; cs1 = tb[1]; }
                bf16_t* rowp = QKV + (size_t)(orow0 + ai * 128 + m * 16) * INC + col0;
#pragma unroll
                for (int bj = 0; bj < 2; ++bj) {
                    f32x4 v0 = acc[ai][bj][m][0], v1 = acc[ai][bj][m][1];
                    if (rope) {
                        const f32x4 c = (f32x4){cs0[0], cs0[2], cs1[0], cs1[2]}, s = (f32x4){cs0[1], cs0[3], cs1[1], cs1[3]};
                        const f32x4 o1 = v0 * c - v1 * s, o2 = v1 * c + v0 * s; v0 = o1; v1 = o2;
                    }
                    v0 = v0 * sc; v1 = v1 * sc;
                    u32x4 w; w.x = cvt_pk_bf16(v0[0], v0[1]); w.y = cvt_pk_bf16(v0[2], v0[3]); w.z = cvt_pk_bf16(v1[0], v1[1]); w.w = cvt_pk_bf16(v1[2], v1[3]);
                    *(u32x4*)(rowp + bj * 128) = w;
                }
            }
    }
};
struct EpiResGate {
    static constexpr bool PERM = false;
    const float* base_lat; const float* base_ctx; float* out_lat; float* out_ctx; const float* gate0;
    __device__ __forceinline__ void operator()(const f32x4 (&acc)[2][2][4][2], const pg8::Unit& u, int wr, int wc, int fr, int fq) const {
        const int pm = u.pm; const int v = pm < 32 ? 0 : (pm < 64 ? 1 : 2);
        const float* base = pm < 64 ? base_lat : base_ctx; float* out = pm < 64 ? out_lat : out_ctx;
        const int row0 = (pm < 64 ? pm : pm - 64) * 256 + wr * 64 + fr;
        const int col0 = u.pn * 256 + wc * 32 + 4 * fq;
        const float* g = gate0 + (size_t)v * 6 * D + col0;
        f32x4 gv[2][2];
#pragma unroll
        for (int bj = 0; bj < 2; ++bj)
#pragma unroll
            for (int n = 0; n < 2; ++n) gv[bj][n] = *(const f32x4*)(g + bj * 128 + n * 16);
#pragma unroll
        for (int ai = 0; ai < 2; ++ai)
#pragma unroll
            for (int m = 0; m < 4; ++m) { const size_t off = (size_t)(row0 + ai * 128 + m * 16) * D + col0;
#pragma unroll
                for (int bj = 0; bj < 2; ++bj)
#pragma unroll
                    for (int n = 0; n < 2; ++n) { const f32x4 bs = *(const f32x4*)(base + off + bj * 128 + n * 16); *(f32x4*)(out + off + bj * 128 + n * 16) = bs + gv[bj][n] * acc[ai][bj][m][n]; }
                if (m & 1) asm volatile("" ::: "memory"); }
    }
};
__device__ __forceinline__ float silu_f(float x) { return x * __builtin_amdgcn_rcpf(1.f + __builtin_amdgcn_exp2f(-x * LOG2E)); }
struct EpiSwiGLU {
    static constexpr bool PERM = true;
    bf16_t* H; int ldc;
    __device__ __forceinline__ void operator()(const f32x4 (&acc)[2][2][4][2], const pg8::Unit& u, int wr, int wc, int fr, int fq) const {
        const int row0 = u.pm * 256 + wr * 64 + fr, col0 = u.pn * 128 + wc * 16 + 4 * fq;
#pragma unroll
        for (int ai = 0; ai < 2; ++ai)
#pragma unroll
            for (int m = 0; m < 4; ++m) { bf16_t* rowp = H + (size_t)(row0 + ai * 128 + m * 16) * ldc + col0;
#pragma unroll
                for (int bj = 0; bj < 2; ++bj) { const f32x4 a = acc[ai][bj][m][0], b = acc[ai][bj][m][1];
                    u32x2 w; w.x = cvt_pk_bf16(silu_f(a[0]) * b[0], silu_f(a[1]) * b[1]); w.y = cvt_pk_bf16(silu_f(a[2]) * b[2], silu_f(a[3]) * b[3]);
                    *(u32x2*)(rowp + bj * 64) = w; } }
    }
};
struct EpiStoreBf16 {
    static constexpr bool PERM = true;
    bf16_t* Y; float scale;
    __device__ __forceinline__ void operator()(const f32x4 (&acc)[2][2][4][2], const pg8::Unit& u, int wr, int wc, int fr, int fq) const {
        const int row0 = u.pm * 256 + wr * 64 + fr, col0 = u.pn * 256 + wc * 32 + 8 * fq;
#pragma unroll
        for (int ai = 0; ai < 2; ++ai)
#pragma unroll
            for (int m = 0; m < 4; ++m) { bf16_t* rowp = Y + (size_t)(row0 + ai * 128 + m * 16) * D + col0;
#pragma unroll
                for (int bj = 0; bj < 2; ++bj) { const f32x4 v0 = acc[ai][bj][m][0] * scale, v1 = acc[ai][bj][m][1] * scale;
                    u32x4 w; w.x = cvt_pk_bf16(v0[0], v0[1]); w.y = cvt_pk_bf16(v0[2], v0[3]); w.z = cvt_pk_bf16(v1[0], v1[1]); w.w = cvt_pk_bf16(v1[2], v1[3]);
                    *(u32x4*)(rowp + bj * 128) = w; } }
    }
};
struct EpiSwiGLU8 {
    static constexpr bool PERM = true;
    unsigned char* H; int ldc;
    __device__ __forceinline__ void operator()(const f32x4 (&acc)[2][2][4][2], const pg8::Unit& u, int wr, int wc, int fr, int fq) const {
        const int row0 = u.pm * 256 + wr * 64 + fr, col0 = u.pn * 128 + wc * 16 + 4 * fq; const float is = 1.f / MOE_W13_SCALE;
#pragma unroll
        for (int ai = 0; ai < 2; ++ai)
#pragma unroll
            for (int m = 0; m < 4; ++m) { unsigned char* rowp = H + (size_t)(row0 + ai * 128 + m * 16) * ldc + col0;
#pragma unroll
                for (int bj = 0; bj < 2; ++bj) { const f32x4 a = acc[ai][bj][m][0] * is, b = acc[ai][bj][m][1] * is;
                    *(unsigned*)(rowp + bj * 64) = pk_fp8x4(silu_f(a[0]) * b[0], silu_f(a[1]) * b[1], silu_f(a[2]) * b[2], silu_f(a[3]) * b[3]); } }
    }
};
struct SchedMoeTail {
    static constexpr bool GATHER = false;
    int first, count; const char* Bt; int K; size_t estride; volatile LAS unsigned* M;
    __device__ __forceinline__ bool next(int i, pg8::Unit& u) const {
        if (i > 0 || first >= count) return false;
        const int sl = first % 7, rest = first / 7; u.pn = rest & 3; u.pm = 128 + (rest >> 2); u.pl = sl;
        int e = 0;
#pragma unroll
        for (int k = 1; k < NEXP; ++k) e += ((int)M[16 + k] <= u.pm) ? 1 : 0;
        u.e = __builtin_amdgcn_readfirstlane(e); return true;
    }
    __device__ __forceinline__ size_t a_tile(const pg8::Unit& u) const { return (size_t)u.pm * 256 * K * 2 + (size_t)u.pl * 512; }
    __device__ __forceinline__ void a_offs(const pg8::Unit&, const int (&)[2], const int (&)[2], unsigned (&)[2][2]) const {}
    __device__ __forceinline__ const char* b_tile(const pg8::Unit& u) const { return Bt + (size_t)u.e * estride + (size_t)u.pn * 256 * K * 2 + (size_t)u.pl * 512; }
};
struct EpiTailPart {
    static constexpr bool PERM = false;
    bf16_t* Yt; float scale;
    __device__ __forceinline__ void operator()(const f32x4 (&acc)[2][2][4][2], const pg8::Unit& u, int wr, int wc, int fr, int fq) const {
        const int row0 = u.pl * 2048 + (u.pm - 128) * 256 + wr * 64 + fr, col0 = u.pn * 256 + wc * 32 + 4 * fq;
#pragma unroll
        for (int ai = 0; ai < 2; ++ai)
#pragma unroll
            for (int m = 0; m < 4; ++m) { bf16_t* rowp = Yt + (size_t)(row0 + ai * 128 + m * 16) * D + col0;
#pragma unroll
                for (int bj = 0; bj < 2; ++bj)
#pragma unroll
                    for (int n = 0; n < 2; ++n) { const f32x4 v = acc[ai][bj][m][n] * scale; u32x2 w; w.x = cvt_pk_bf16(v[0], v[1]); w.y = cvt_pk_bf16(v[2], v[3]); *(u32x2*)(rowp + bj * 128 + n * 16) = w; } }
    }
};

struct ThinInProj {
    bf16_t* QKV; int col_off;
    __device__ __forceinline__ void operator()(int row, int col, const float (&v)[8]) const {
        const int c = col + col_off; const float sc = c < C_KA ? C2 : 1.f;
        u32x4 w; w.x = cvt_pk_bf16(v[0] * sc, v[1] * sc); w.y = cvt_pk_bf16(v[2] * sc, v[3] * sc); w.z = cvt_pk_bf16(v[4] * sc, v[5] * sc); w.w = cvt_pk_bf16(v[6] * sc, v[7] * sc);
        *(u32x4*)(QKV + (size_t)((row >> 8) * KVR + (row & 255)) * INC + c) = w;
    }
};
struct ThinResGate {
    const float* base; float* out; const float* gate;
    __device__ __forceinline__ void operator()(int row, int col, const float (&v)[8]) const {
        const size_t off = (size_t)row * D + col;
        const f32x4 g0 = *(const f32x4*)(gate + col), g1 = *(const f32x4*)(gate + col + 4), b0 = *(const f32x4*)(base + off), b1 = *(const f32x4*)(base + off + 4);
        *(f32x4*)(out + off) = b0 + g0 * (f32x4){v[0], v[1], v[2], v[3]}; *(f32x4*)(out + off + 4) = b1 + g1 * (f32x4){v[4], v[5], v[6], v[7]};
    }
};
struct ThinSwiGLU {
    bf16_t* H; int ldc;
    __device__ __forceinline__ void operator()(int row, int col, const float (&v)[8]) const {
        u32x2 w; w.x = cvt_pk_bf16(silu_f(v[0]) * v[4], silu_f(v[1]) * v[5]); w.y = cvt_pk_bf16(silu_f(v[2]) * v[6], silu_f(v[3]) * v[7]);
        *(u32x2*)(H + (size_t)row * ldc + (col >> 1)) = w;
    }
};
template <class Epi8>
__device__ __forceinline__ void thin_gemm(const Ctx& X0, const bf16_t* A, const bf16_t* Bt, int N, int K, const Epi8& E, int first, int stride) {
    const Ctx X = fresh(X0);
    constexpr int PST = 68, TB = 16384;
    const int lane = X.lane, wid = X.wave, r32 = lane & 31, hi = lane >> 5, mi = wid & 1, ni = (wid >> 1) & 1, kh = wid >> 2;
    LAS char* L = (LAS char*)X.lds;
    LAS float* Pl = (LAS float*)(L + 4 * TB);
    const int srow = X.tid >> 3, sch = X.tid & 7;
    const int sw0 = srow * 256 + ((sch ^ (srow & 7)) * 16), sw1 = sw0 + 128;
    const int ra = 32 * mi + r32, rb = 32 * ni + r32, fa = ra * 256, fb = rb * 256, xa = ra & 7, xb = rb & 7;
    const int nTn = N / 64, nk = K / 128;
    for (int tile = first; tile < 8 * nTn; tile += stride) {
        const int tm = tile & 7, tn = tile >> 3;
        const bf16_t* ag = A + (size_t)(tm * 64 + srow) * K + sch * 8; const bf16_t* bg = Bt + (size_t)(tn * 64 + srow) * K + sch * 8;
        bf16x8 ea0 = *(const bf16x8*)ag, ea1 = *(const bf16x8*)(ag + 64), eb0 = *(const bf16x8*)bg, eb1 = *(const bf16x8*)(bg + 64);
        bf16x8 oa0 = *(const bf16x8*)(ag + 128), oa1 = *(const bf16x8*)(ag + 192), ob0 = *(const bf16x8*)(bg + 128), ob1 = *(const bf16x8*)(bg + 192);
        f32x16 c = {};
#define THIN_COMPUTE(ta, tb) do { _Pragma("unroll") for (int jj = 0; jj < 4; ++jj) { const int ci = 2 * (4 * kh + jj) + hi; \
            const bf16x8 af = *(const LAS bf16x8*)((ta) + fa + ((ci ^ xa) * 16)), bf = *(const LAS bf16x8*)((tb) + fb + ((ci ^ xb) * 16)); \
            c = __builtin_amdgcn_mfma_f32_32x32x16_bf16(af, bf, c, 0, 0, 0); } } while (0)
        for (int s = 0; s < nk; s += 2) {
            LAS char* ta = L; LAS char* tb = L + 2 * TB;
            *(LAS bf16x8*)(ta + sw0) = ea0; *(LAS bf16x8*)(ta + sw1) = ea1; *(LAS bf16x8*)(tb + sw0) = eb0; *(LAS bf16x8*)(tb + sw1) = eb1;
            __syncthreads();
            if (s + 2 < nk) { const int ko = (s + 2) * 128; ea0 = *(const bf16x8*)(ag + ko); ea1 = *(const bf16x8*)(ag + ko + 64); eb0 = *(const bf16x8*)(bg + ko); eb1 = *(const bf16x8*)(bg + ko + 64); }
            THIN_COMPUTE(ta, tb);
            ta += TB; tb += TB;
            *(LAS bf16x8*)(ta + sw0) = oa0; *(LAS bf16x8*)(ta + sw1) = oa1; *(LAS bf16x8*)(tb + sw0) = ob0; *(LAS bf16x8*)(tb + sw1) = ob1;
            __syncthreads();
            if (s + 3 < nk) { const int ko = (s + 3) * 128; oa0 = *(const bf16x8*)(ag + ko); oa1 = *(const bf16x8*)(ag + ko + 64); ob0 = *(const bf16x8*)(bg + ko); ob1 = *(const bf16x8*)(bg + ko + 64); }
            THIN_COMPUTE(ta, tb);
        }
#undef THIN_COMPUTE
        LAS float* pw = Pl + kh * 64 * PST + ni * 32 + r32;
#pragma unroll
        for (int r = 0; r < 16; ++r) pw[(32 * mi + (r & 3) + 8 * (r >> 2) + 4 * hi) * PST] = c[r];
        __syncthreads();
        { const int row = X.tid >> 3, c8 = (X.tid & 7) * 8; float v[8];
            const LAS float* pr = Pl + row * PST + c8;
            const f32x4 s0 = *(const LAS f32x4*)pr + *(const LAS f32x4*)(pr + 64 * PST), s1 = *(const LAS f32x4*)(pr + 4) + *(const LAS f32x4*)(pr + 64 * PST + 4);
            v[0] = s0[0]; v[1] = s0[1]; v[2] = s0[2]; v[3] = s0[3]; v[4] = s1[0]; v[5] = s1[1]; v[6] = s1[2]; v[7] = s1[3];
            E(tm * 64 + row, tn * 64 + c8, v); }
        __syncthreads();
    }
}

__device__ __forceinline__ unsigned f2bf(float f) { unsigned u = __builtin_bit_cast(unsigned, f); return (u + 0x7fffu + ((u >> 16) & 1u)) >> 16; }
__device__ __forceinline__ unsigned pk2(float lo, float hi) { return f2bf(lo) | (f2bf(hi) << 16); }
template <int MODE> __device__ __forceinline__ int dest_row(int n) {
    if (MODE == 1) { if ((n >= C_QB && n < C_KA) || (n >= C_KB && n < C_VA)) { const int i = n & 63, base = n & ~63; return base + ((i < 32) ? 8 * (i >> 2) + (i & 3) : 8 * ((i - 32) >> 2) + 4 + (i & 3)); } return n; }
    if (MODE == 2) return 8 * (n >> 2) + (n & 3);
    if (MODE == 3) return 8 * (n >> 2) + 4 + (n & 3);
    return n;
}
template <int MODE> __device__ __forceinline__ void p0_transpose_item(const float* W, int K, int N, bf16_t* WT, LAS float* scr, int item, int lane) {
    const int nblk = N / 32, kb = item / nblk, nb = item % nblk, k0 = 64 * kb, n0 = 32 * nb;
#pragma unroll 8
    for (int i = 0; i < 32; ++i) { const int kk = 2 * i + (lane >> 5); scr[kk * 33 + (lane & 31)] = W[(size_t)(k0 + kk) * N + n0 + (lane & 31)]; }
    LDS_WAIT(); asm volatile("" ::: "memory");
    const int c = lane & 7;
#pragma unroll
    for (int j = 0; j < 4; ++j) { const int n = (lane >> 3) + 8 * j; const LAS float* s = scr + (8 * c) * 33 + n;
        u32x4 o; o.x = pk2(s[0 * 33], s[1 * 33]); o.y = pk2(s[2 * 33], s[3 * 33]); o.z = pk2(s[4 * 33], s[5 * 33]); o.w = pk2(s[6 * 33], s[7 * 33]);
        st16_wt(WT + (size_t)dest_row<MODE>(n0 + n) * K + k0 + 8 * c, o); }
    LDS_WAIT(); asm volatile("" ::: "memory");
}
template <int MODE> __device__ __forceinline__ void p0_transpose_item_f8(const float* W, int K, int N, unsigned char* WT8, float scale, LAS float* scr, int item, int lane) {
    const int nblk = N / 32, kb = item / nblk, nb = item % nblk, k0 = 64 * kb, n0 = 32 * nb;
#pragma unroll 8
    for (int i = 0; i < 32; ++i) { const int kk = 2 * i + (lane >> 5); scr[kk * 33 + (lane & 31)] = W[(size_t)(k0 + kk) * N + n0 + (lane & 31)] * scale; }
    LDS_WAIT(); asm volatile("" ::: "memory");
    const int c = lane & 7;
#pragma unroll
    for (int j = 0; j < 4; ++j) { const int n = (lane >> 3) + 8 * j; const LAS float* q = scr + (8 * c) * 33 + n;
        u32x2 o; o.x = pk_fp8x4(q[0 * 33], q[1 * 33], q[2 * 33], q[3 * 33]); o.y = pk_fp8x4(q[4 * 33], q[5 * 33], q[6 * 33], q[7 * 33]);
        st8_wt(WT8 + (size_t)dest_row<MODE>(n0 + n) * K + k0 + 8 * c, o); }
    LDS_WAIT(); asm volatile("" ::: "memory");
}
__device__ __forceinline__ void sincos_d(double x, double& s, double& c) {
    const double k = __builtin_rint(x * 0.63661977236758134308);
    double r = __builtin_fma(-k, 1.57079632679489655800e+00, x); r = __builtin_fma(-k, 6.12323399573676603587e-17, r);
    const double r2 = r * r;
    double sp = -7.6471637318198164759e-13; sp = sp * r2 + 1.6059043836821614599e-10; sp = sp * r2 - 2.5052108385441718775e-08; sp = sp * r2 + 2.7557319223985890653e-06;
    sp = sp * r2 - 1.9841269841269841270e-04; sp = sp * r2 + 8.3333333333333333333e-03; sp = sp * r2 - 1.6666666666666666667e-01; const double sr = r + r * r2 * sp;
    double cp = 4.7794773323873852974e-14; cp = cp * r2 - 1.1470745597729724714e-11; cp = cp * r2 + 2.0876756987868098979e-09; cp = cp * r2 - 2.7557319223985890653e-07;
    cp = cp * r2 + 2.4801587301587301587e-05; cp = cp * r2 - 1.3888888888888888889e-03; cp = cp * r2 + 4.1666666666666666667e-02; cp = cp * r2 - 0.5; const double cr = 1.0 + r2 * cp;
    const int q = ((int)k) & 3;
    s = (q == 0) ? sr : (q == 1) ? cr : (q == 2) ? -sr : -cr;
    c = (q == 0) ? cr : (q == 1) ? -sr : (q == 2) ? -cr : sr;
}
__device__ __forceinline__ float inv_freq(int f) {
    float v = (f & 3) == 0 ? 1.0f : (f & 3) == 1 ? 0.5623413251903491f : (f & 3) == 2 ? 0.31622776601683794f : 0.1778279410038923f;
    const int d = f >> 2; v *= (d == 0) ? 1.0f : (d == 1) ? 0.1f : (d == 2) ? 0.01f : 0.001f; return v;
}
struct P0D { const float* W; unsigned char* WT; int K, N, item, mode, f8; float scale; };
constexpr int I_IN = 16 * 96, I_OUT = 16 * 32, I_F13 = 16 * 88, I_F2 = 44 * 32, I_M13 = 16 * 112, I_M2 = 56 * 32;
constexpr int P0_NITEMS = 2 * I_IN + 2 * I_OUT + 2 * I_F13 + I_F2 + 16 * I_M13 + 8 * I_M2;
__device__ __forceinline__ P0D p0_decode(const Ctx& X, const Params& P, int it) {
    P0D d; int r = it; d.scale = 1.f; d.f8 = 0;
    if (r < 2 * I_IN) { const int l = r / I_IN; d.W = P.w_in + (size_t)l * D * INC; d.K = D; d.N = INC; d.WT = X.ws + WS_WIN + (size_t)l * INC * D * 2; d.mode = 1; d.item = r % I_IN; return d; } r -= 2 * I_IN;
    if (r < 2 * I_OUT) { const int l = r / I_OUT; d.W = P.w_out + (size_t)l * D * D; d.K = D; d.N = D; d.WT = X.ws + WS_WOUT + (size_t)l * D * D * 2; d.mode = 0; d.item = r % I_OUT; return d; } r -= 2 * I_OUT;
    if (r < I_F13) { d.W = P.ffn_w1; d.K = D; d.N = DFF; d.WT = X.ws + WS_W13; d.mode = 2; d.item = r; return d; } r -= I_F13;
    if (r < I_F13) { d.W = P.ffn_w3; d.K = D; d.N = DFF; d.WT = X.ws + WS_W13; d.mode = 3; d.item = r; return d; } r -= I_F13;
    if (r < I_F2) { d.W = P.ffn_w2; d.K = DFF; d.N = D; d.WT = X.ws + WS_W2; d.mode = 0; d.item = r; return d; } r -= I_F2;
    d.f8 = 1;
    if (r < 8 * I_M13) { const int e = r / I_M13; d.W = P.moe_w1 + (size_t)e * D * DEXP; d.K = D; d.N = DEXP; d.WT = X.ws + WS_MW13 + (size_t)e * 2 * DEXP * D; d.mode = 2; d.item = r % I_M13; d.scale = MOE_W13_SCALE; return d; } r -= 8 * I_M13;
    if (r < 8 * I_M13) { const int e = r / I_M13; d.W = P.moe_w3 + (size_t)e * D * DEXP; d.K = D; d.N = DEXP; d.WT = X.ws + WS_MW13 + (size_t)e * 2 * DEXP * D; d.mode = 3; d.item = r % I_M13; d.scale = MOE_W13_SCALE; return d; } r -= 8 * I_M13;
    { const int e = r / I_M2; d.W = P.moe_w2 + (size_t)e * DEXP * D; d.K = DEXP; d.N = D; d.WT = X.ws + WS_MW2 + (size_t)e * D * DEXP; d.mode = 0; d.item = r % I_M2; d.scale = MOE_W2_SCALE; return d; }
}
__device__ __forceinline__ void p0_prologue(const Ctx& X0, const Params& P) {
    const Ctx X = fresh(X0);
    LAS float* scr = (LAS float*)(X.lds + X.wave * 16384);
    const int gw = X.vcu * NWAVES + X.wave, NGW = X.G * NWAVES;
    float vn[32];
    constexpr int MOD_ITEMS = 2 * (6 * D / 64);
    if (X.vcu < MOD_ITEMS) {
        LAS float* sv = (LAS float*)(X.lds);
        LAS float* red = (LAS float*)(X.lds + 16384);
        for (int i = X.tid; i < 3 * D; i += NWAVES * 64) { const int v = i / D, k = i % D; const float cv = v < 2 ? P.c[v * D + k] : P.c_ctx[k]; sv[i] = cv / (1.f + __expf(-cv)); }
        __syncthreads();
        const int l = X.vcu / 96, n0 = (X.vcu % 96) * 64;
        const int kg = X.tid >> 4, cl = X.tid & 15;
        const float* W = P.ada_w + (size_t)l * D * 6 * D + n0 + cl * 4;
        f32x4 a0 = {0.f, 0.f, 0.f, 0.f}, a1 = a0, a2 = a0;
#pragma unroll 8
        for (int kk = 0; kk < 32; ++kk) { const int k = kg * 32 + kk; const f32x4 w = *(const f32x4*)(W + (size_t)k * 6 * D); a0 += w * sv[k]; a1 += w * sv[D + k]; a2 += w * sv[2 * D + k]; }
#pragma unroll
        for (int j = 0; j < 4; ++j) { red[(kg * 3 + 0) * 64 + cl * 4 + j] = a0[j]; red[(kg * 3 + 1) * 64 + cl * 4 + j] = a1[j]; red[(kg * 3 + 2) * 64 + cl * 4 + j] = a2[j]; }
        __syncthreads();
        if (X.tid < 192) { const int v = X.tid / 64, cc = X.tid % 64; float s = 0.f;
            for (int g = 0; g < 32; ++g) s += red[(g * 3 + v) * 64 + cc];
            ((float*)(X.ws + WS_MODS))[(size_t)(l * 3 + v) * 6 * D + n0 + cc] = s + P.ada_b[l * 6 * D + n0 + cc]; }
        __syncthreads();
    } else if (X.vcu == MOD_ITEMS) {
        f32x2* tabR = (f32x2*)(X.ws + WS_TABR); f32x2* tabC = (f32x2*)(X.ws + WS_TABC);
        for (int i = X.tid; i < 192 * 16; i += NWAVES * 64) { const int pos = i >> 4, f = i & 15; const int p = pos < 128 ? pos : pos - 128;
            const float ang = (float)p * inv_freq(f); double s, c; sincos_d((double)ang, s, c);
            const f32x2 cs = {(float)c, (float)s}; if (pos < 128) tabR[pos * 16 + f] = cs; else tabC[(pos - 128) * 16 + f] = cs; }
        if (X.wave < 2) { const float* dl = P.diff_lambda + X.wave * 256;
            const float s1 = wave_sum(dl[X.lane] * dl[64 + X.lane]), s2 = wave_sum(dl[128 + X.lane] * dl[192 + X.lane]);
            const float linit = X.wave == 0 ? 0.2f : (0.8f - 0.6f * 0.74081822068171786607f);
            if (X.lane == 0) ((float*)(X.ws + WS_LAM))[X.wave] = __expf(s1) - __expf(s2) + linit; }
    }
    for (int it = gw; it < P0_NITEMS; ) {
        const P0D d = p0_decode(X, P, it);
        const int nblk = d.N / 32, kb = d.item / nblk, nb = d.item % nblk, k0 = 64 * kb, n0 = 32 * nb;
        float v[32];
        if (it == gw) { const float* src = d.W + (size_t)(k0 + (X.lane >> 5)) * d.N + n0 + (X.lane & 31);
#pragma unroll
            for (int i = 0; i < 32; ++i) v[i] = src[(size_t)(2 * i) * d.N]; }
        else {
#pragma unroll
            for (int i = 0; i < 32; ++i) v[i] = vn[i]; }
#pragma unroll
        for (int i = 0; i < 32; ++i) scr[(2 * i + (X.lane >> 5)) * 33 + (X.lane & 31)] = v[i] * d.scale;
        LDS_WAIT(); asm volatile("" ::: "memory");
        const int itn = it + NGW;
        if (itn < P0_NITEMS) { const P0D dn = p0_decode(X, P, itn);
            const int nblkn = dn.N / 32, kbn = dn.item / nblkn, nbn = dn.item % nblkn;
            const float* src = dn.W + (size_t)(64 * kbn + (X.lane >> 5)) * dn.N + 32 * nbn + (X.lane & 31);
#pragma unroll
            for (int i = 0; i < 32; ++i) vn[i] = src[(size_t)(2 * i) * dn.N]; }
        const int c = X.lane & 7;
#pragma unroll
        for (int j = 0; j < 4; ++j) { const int n = (X.lane >> 3) + 8 * j; const LAS float* q = scr + (8 * c) * 33 + n;
            const int dr = d.mode == 1 ? dest_row<1>(n0 + n) : d.mode == 2 ? dest_row<2>(n0 + n) : d.mode == 3 ? dest_row<3>(n0 + n) : n0 + n;
            const size_t eo = (size_t)dr * d.K + k0 + 8 * c;
            if (d.f8) { u32x2 o; o.x = pk_fp8x4(q[0 * 33], q[1 * 33], q[2 * 33], q[3 * 33]); o.y = pk_fp8x4(q[4 * 33], q[5 * 33], q[6 * 33], q[7 * 33]); st8_wt(d.WT + eo, o); }
            else { u32x4 o; o.x = pk2(q[0 * 33], q[1 * 33]); o.y = pk2(q[2 * 33], q[3 * 33]); o.z = pk2(q[4 * 33], q[5 * 33]); o.w = pk2(q[6 * 33], q[7 * 33]); st16_wt(d.WT + 2 * eo, o); } }
        LDS_WAIT(); asm volatile("" ::: "memory");
        it = itn;
    }
}

__device__ __forceinline__ void norm_phase(const Ctx& X0, const float* xlat, const float* xctx, const float* shift0, const float* scale0, bf16_t* H, int rows) {
    const Ctx X = fresh(X0);
    const int gw = X.vcu * NWAVES + X.wave, NGW = X.G * NWAVES;
#define NP_V(m_) ((m_) < SEQ ? 0 : ((m_) < NLAT ? 1 : 2))
#define NP_SRC(m_) ((const GAS f32x4*)((m_) < NLAT ? xlat + (size_t)(m_) * D : xctx + (size_t)((m_) - NLAT) * D) + X.lane)
    for (int m0 = gw; m0 < rows; m0 += 4 * NGW) {
        const int ml = m0 + 3 * NGW, v0 = NP_V(m0);
        if (ml < rows && NP_V(ml) == v0) {
            f32x4 xv[4][4], sh[4], sc[4]; float s2[4];
#pragma unroll
            for (int r = 0; r < 4; ++r) { const int m = m0 + r * NGW; const GAS f32x4* xr = NP_SRC(m);
#pragma unroll
                for (int j = 0; j < 4; ++j) xv[r][j] = xr[64 * j]; }
            const f32x4* shp = (const f32x4*)(shift0 + (size_t)v0 * 6 * D) + X.lane; const f32x4* scp = (const f32x4*)(scale0 + (size_t)v0 * 6 * D) + X.lane;
#pragma unroll
            for (int j = 0; j < 4; ++j) { sh[j] = shp[64 * j]; sc[j] = scp[64 * j] + 1.f; }
#pragma unroll
            for (int r = 0; r < 4; ++r) { s2[r] = 0.f;
#pragma unroll
                for (int j = 0; j < 4; ++j) s2[r] += (xv[r][j].x * xv[r][j].x + xv[r][j].y * xv[r][j].y) + (xv[r][j].z * xv[r][j].z + xv[r][j].w * xv[r][j].w); }
#pragma unroll
            for (int r = 0; r < 4; ++r) s2[r] = 1.f / sqrtf(wave_sum(s2[r]) * (1.f / D) + EPS);
#pragma unroll
            for (int r = 0; r < 4; ++r) { GAS u32x2* o8 = (GAS u32x2*)(H + (size_t)(m0 + r * NGW) * D) + X.lane;
#pragma unroll
                for (int j = 0; j < 4; ++j) { const f32x4 h = xv[r][j] * s2[r] * sc[j] + sh[j];
                    u32x2 w; w.x = cvt_pk_bf16(h.x, h.y); w.y = cvt_pk_bf16(h.z, h.w); st8_wt((void*)(o8 + 64 * j), w); } }
        } else {
            for (int m = m0; m < rows && m <= ml; m += NGW) {
                const int v = NP_V(m);
                const GAS f32x4* xr = NP_SRC(m);
                const f32x4* shp = (const f32x4*)(shift0 + (size_t)v * 6 * D) + X.lane; const f32x4* scp = (const f32x4*)(scale0 + (size_t)v * 6 * D) + X.lane;
                f32x4 xv[4]; float s2 = 0.f;
#pragma unroll
                for (int j = 0; j < 4; ++j) { xv[j] = xr[64 * j]; s2 += (xv[j].x * xv[j].x + xv[j].y * xv[j].y) + (xv[j].z * xv[j].z + xv[j].w * xv[j].w); }
                const float rstd = 1.f / sqrtf(wave_sum(s2) * (1.f / D) + EPS);
                GAS u32x2* o8 = (GAS u32x2*)(H + (size_t)m * D) + X.lane;
#pragma unroll
                for (int j = 0; j < 4; ++j) { const f32x4 sh = shp[64 * j], sc = scp[64 * j]; const f32x4 h = xv[j] * rstd * (sc + 1.f) + sh;
                    u32x2 w; w.x = cvt_pk_bf16(h.x, h.y); w.y = cvt_pk_bf16(h.z, h.w); st8_wt((void*)(o8 + 64 * j), w); }
            }
        }
    }
#undef NP_V
#undef NP_SRC
}

__device__ __forceinline__ void conv_phase(const Ctx& X0, const bf16_t* QKV, bf16_t* CAT, const float* cw, int rows) {
    const Ctx X = fresh(X0);
    const int gt = X.vcu * (NWAVES * 64) + X.tid, NT = X.G * NWAVES * 64;
    for (int it = gt; it < rows * 32; it += NT) {
        const int m = it >> 5, c8 = (it & 31) * 8;
        int b, t, n, R;
        if (m < NLAT) { b = m >> 13; t = m & (SEQ - 1); n = SEQ; R = b * KVR + CTXL + t; } else { const int mm = m - NLAT; b = mm >> 8; t = mm & (CTXL - 1); n = CTXL; R = b * KVR + t; }
        float acc[8];
#pragma unroll
        for (int j = 0; j < 8; ++j) acc[j] = 0.f;
#pragma unroll
        for (int dt = -1; dt <= 1; ++dt) {
            if (t + dt < 0 || t + dt >= n) continue;
            const bf16_t* rp = QKV + (size_t)(R + dt) * INC;
            const bf16x8 xi = *(const bf16x8*)(rp + C_XIN + c8), cg = *(const bf16x8*)(rp + C_CG + c8);
            const float* w = cw + (dt + 1) * 256 + c8;
#pragma unroll
            for (int j = 0; j < 8; ++j) acc[j] += w[j] * (bf2f((unsigned short)xi[j]) * bf2f((unsigned short)cg[j]));
        }
        const bf16x8 bg = *(const bf16x8*)(QKV + (size_t)R * INC + C_BG + c8);
        u32x4 o;
        o.x = cvt_pk_bf16(acc[0] * bf2f((unsigned short)bg[0]), acc[1] * bf2f((unsigned short)bg[1])); o.y = cvt_pk_bf16(acc[2] * bf2f((unsigned short)bg[2]), acc[3] * bf2f((unsigned short)bg[3]));
        o.z = cvt_pk_bf16(acc[4] * bf2f((unsigned short)bg[4]), acc[5] * bf2f((unsigned short)bg[5])); o.w = cvt_pk_bf16(acc[6] * bf2f((unsigned short)bg[6]), acc[7] * bf2f((unsigned short)bg[7]));
        *(u32x4*)(CAT + (size_t)m * D + 768 + c8) = o;
    }
}

namespace att {
constexpr int KCH = 1040;
constexpr int KT_BYTES = 8 * KCH;
constexpr float THR = 8.f;
__device__ __forceinline__ int crow(int r, int hi) { return (r & 3) + 8 * (r >> 2) + 4 * hi; }
template <int W> __device__ __forceinline__ int v_st(int k, int c) { const int kk = (k & ~0xC) | ((k & 4) << 1) | ((k & 8) >> 1); return ((kk >> 3) * W + (c >> 5)) * 512 + ((kk & 7) * 32 + (c & 31)) * 2; }
template <int W> __device__ __forceinline__ int v_st_nat(int k, int c) { return ((k >> 3) * W + (c >> 5)) * 512 + ((k & 7) * 32 + (c & 31)) * 2; }
__device__ __forceinline__ int v_rd_base(int lane) { return ((lane & 3) << 3) | (((lane >> 2) & 3) << 6) | (((lane >> 4) & 1) << 5) | (((lane >> 5) & 1) << 8); }
template <int OFF> __device__ __forceinline__ s16x4 tr_read(int vb) { s16x4 r; asm volatile("ds_read_b64_tr_b16 %0, %1 offset:%2" : "=&v"(r) : "v"(vb), "i"(OFF) : "memory"); return r; }
template <int D0, int W> __device__ __forceinline__ void pv_one(f32x16& od, int vb, bf16x8 pa0, bf16x8 pa1, bf16x8 pa2, bf16x8 pa3) {
    constexpr int KS = W * 1024, HF = W * 512, B = D0 * 512;
    const s16x4 l0 = tr_read<B>(vb), h0 = tr_read<B + HF>(vb), l1 = tr_read<B + KS>(vb), h1 = tr_read<B + KS + HF>(vb);
    const s16x4 l2 = tr_read<B + 2 * KS>(vb), h2 = tr_read<B + 2 * KS + HF>(vb), l3 = tr_read<B + 3 * KS>(vb), h3 = tr_read<B + 3 * KS + HF>(vb);
    asm volatile("s_waitcnt lgkmcnt(0)" ::: "memory"); __builtin_amdgcn_sched_barrier(0);
#define ATT_PK(L, H) (bf16x8){L[0], L[1], L[2], L[3], H[0], H[1], H[2], H[3]}
    od = __builtin_amdgcn_mfma_f32_32x32x16_bf16(pa0, ATT_PK(l0, h0), od, 0, 0, 0);
    od = __builtin_amdgcn_mfma_f32_32x32x16_bf16(pa1, ATT_PK(l1, h1), od, 0, 0, 0);
    od = __builtin_amdgcn_mfma_f32_32x32x16_bf16(pa2, ATT_PK(l2, h2), od, 0, 0, 0);
    od = __builtin_amdgcn_mfma_f32_32x32x16_bf16(pa3, ATT_PK(l3, h3), od, 0, 0, 0);
#undef ATT_PK
}
__device__ __forceinline__ void qkt64(f32x16& p0, f32x16& p1, const LAS char* Ks, const bf16x8 (&qr)[4], int r32, int hi) {
    const LAS char* kb = Ks + hi * KCH + r32 * 16;
    p0 = (f32x16){}; p1 = (f32x16){};
#pragma unroll
    for (int d0 = 0; d0 < 4; ++d0) {
        const bf16x8 b0 = *(const LAS bf16x8*)(kb + d0 * 2 * KCH), b1 = *(const LAS bf16x8*)(kb + d0 * 2 * KCH + 512);
        p0 = __builtin_amdgcn_mfma_f32_32x32x16_bf16(b0, qr[d0], p0, 0, 0, 0);
        p1 = __builtin_amdgcn_mfma_f32_32x32x16_bf16(b1, qr[d0], p1, 0, 0, 0); }
}
__device__ __forceinline__ void qkt64s(f32x16& p0, f32x16& p1, const LAS char* kb, int kx, const bf16x8 (&qr)[4]) {
    p0 = (f32x16){}; p1 = (f32x16){};
#pragma unroll
    for (int d0 = 0; d0 < 4; ++d0) {
        const bf16x8 b0 = *(const LAS bf16x8*)(kb + (kx ^ (32 * d0))), b1 = *(const LAS bf16x8*)(kb + (kx ^ (32 * d0)) + 4096);
        p0 = __builtin_amdgcn_mfma_f32_32x32x16_bf16(b0, qr[d0], p0, 0, 0, 0);
        p1 = __builtin_amdgcn_mfma_f32_32x32x16_bf16(b1, qr[d0], p1, 0, 0, 0); }
}
__device__ __forceinline__ void softmax_tile(f32x16& p0, f32x16& p1, float& m_reg, float& l_reg, float& alpha, bf16x8& pa0, bf16x8& pa1, bf16x8& pa2, bf16x8& pa3) {
    float pmax = p0[0];
#pragma unroll
    for (int r = 1; r < 16; ++r) pmax = fmaxf(pmax, p0[r]);
#pragma unroll
    for (int r = 0; r < 16; ++r) pmax = fmaxf(pmax, p1[r]);
    { auto rr = __builtin_amdgcn_permlane32_swap(__float_as_uint(pmax), __float_as_uint(pmax), false, false); pmax = fmaxf(__uint_as_float(rr[0]), __uint_as_float(rr[1])); }
    float mn;
    if (__builtin_expect(__all(pmax - m_reg <= THR), 1)) { mn = m_reg; alpha = 1.f; }
    else { mn = fmaxf(m_reg, pmax); alpha = __builtin_amdgcn_exp2f(m_reg - mn); m_reg = mn; }
    float ps = 0.f;
#pragma unroll
    for (int r = 0; r < 16; ++r) { p0[r] = __builtin_amdgcn_exp2f(p0[r] - mn); ps += p0[r]; }
#pragma unroll
    for (int r = 0; r < 16; ++r) { p1[r] = __builtin_amdgcn_exp2f(p1[r] - mn); ps += p1[r]; }
    { auto rr = __builtin_amdgcn_permlane32_swap(__float_as_uint(ps), __float_as_uint(ps), false, false); ps = __uint_as_float(rr[0]) + __uint_as_float(rr[1]); }
    l_reg = l_reg * alpha + ps;
#define ATT_PK4(P, BASE, OUT) do { const unsigned a0 = cvt_pk_bf16(P[BASE + 0], P[BASE + 1]), a1 = cvt_pk_bf16(P[BASE + 2], P[BASE + 3]); \
    const unsigned b0 = cvt_pk_bf16(P[BASE + 4], P[BASE + 5]), b1 = cvt_pk_bf16(P[BASE + 6], P[BASE + 7]); \
    auto r0 = __builtin_amdgcn_permlane32_swap(a0, b0, false, false); auto r1 = __builtin_amdgcn_permlane32_swap(a1, b1, false, false); \
    u32x4 w = {r0[0], r1[0], r0[1], r1[1]}; OUT = __builtin_bit_cast(bf16x8, w); } while (0)
    ATT_PK4(p0, 0, pa0); ATT_PK4(p0, 8, pa1); ATT_PK4(p1, 0, pa2); ATT_PK4(p1, 8, pa3);
#undef ATT_PK4
}

template <bool CTXQ>
__device__ __forceinline__ void diff_unit_safe(const Ctx& X0, const bf16_t* QKV, bf16_t* CAT, int b, int hd, int qblk, float lam, const float* gain, float oscale) {
    const Ctx X = fresh(X0);
    constexpr int K_OFF = 0, V_OFF = 4 * KT_BYTES  , WS_OFF = V_OFF + 2 * 16384  ;
    const int tid = X.tid, lane = X.lane, wid = X.wave, r32 = lane & 31, hi = lane >> 5, jh = wid >> 2, qsub = wid & 3;
    LAS char* L = (LAS char*)X.lds;
    LAS float* wsf = (LAS float*)(L + WS_OFF) + wid * 64;
    const int NT = CTXQ ? CTXL / 64 : KVR / 64;
    const int kbase = b * KVR;
    const int qrow = b * KVR + (CTXQ ? 0 : CTXL) + qblk * 128 + qsub * 32 + r32;
    bf16x8 qr[4];
#pragma unroll
    for (int d0 = 0; d0 < 4; ++d0) qr[d0] = *(const bf16x8*)(QKV + (size_t)qrow * INC + C_QB + (2 * hd + jh) * 64 + d0 * 16 + hi * 8);
    const int khh = tid >> 8, kr = (tid >> 3) & 31, kc = tid & 7;
    const bf16_t* kg = QKV + (size_t)(kbase + kr) * INC + C_KB + (2 * hd + khh) * 64 + kc * 8;
    const int kl = K_OFF + khh * KT_BYTES + kc * KCH + kr * 16;
    const int sr = tid >> 4, sc = (tid & 15) * 8;
    const bf16_t* vg = QKV + (size_t)(kbase + sr) * INC + C_VB + hd * 128 + sc;
    const int vl0 = V_OFF + v_st<4>(sr, sc), vl1 = V_OFF + v_st<4>(32 + sr, sc);
    const int vb0 = (int)(uintptr_t)X.ldsg + V_OFF + v_rd_base(lane);
    const int ka0 = (int)(uintptr_t)X.ldsg + K_OFF + jh * KT_BYTES + hi * KCH + r32 * 16;
    bf16x8 ks0, ks1, vs0, vs1;
#define DF_SLOAD(t) do { const size_t go = (size_t)(t) * 64 * INC; ks0 = *(const bf16x8*)(kg + go); ks1 = *(const bf16x8*)(kg + go + 32 * INC); vs0 = *(const bf16x8*)(vg + go); vs1 = *(const bf16x8*)(vg + go + 32 * INC); } while (0)
#define DF_SWRITE(buf) do { *(LAS bf16x8*)(L + kl + (buf) * 2 * KT_BYTES) = ks0; *(LAS bf16x8*)(L + kl + (buf) * 2 * KT_BYTES + 512) = ks1; \
        *(LAS bf16x8*)(L + vl0 + (buf) * 16384) = vs0; *(LAS bf16x8*)(L + vl1 + (buf) * 16384) = vs1; } while (0)
    float m_reg = -1e30f, l_reg = 0.f; f32x16 o[4] = {};
    DF_SLOAD(0); VM_WAIT(); DF_SWRITE(0);
    for (int t = 0; t < NT; ++t) {
        const int buf = t & 1;
        __syncthreads();
        if (t + 1 < NT) DF_SLOAD(t + 1);
        float alpha; bf16x8 pa0, pa1, pa2, pa3;
        bf16x8 kf[8]; s16x4 vl[16], vh[16]; f32x16 p0 = {}, p1 = {};
        { const int ka = ka0 + buf * 2 * KT_BYTES, vb = vb0 + buf * 16384;
#pragma unroll
          for (int i = 0; i < 8; ++i) asm volatile("ds_read_b128 %0, %1 offset:%2" : "=&v"(kf[i]) : "v"(ka), "i"((i >> 1) * 2 * KCH + (i & 1) * 512) : "memory");
#define DF_VRD(i) do { asm volatile("ds_read_b64_tr_b16 %0, %1 offset:%2" : "=&v"(vl[i]) : "v"(vb), "i"(((i) >> 2) * 512 + ((i) & 3) * 4096) : "memory"); \
                       asm volatile("ds_read_b64_tr_b16 %0, %1 offset:%2" : "=&v"(vh[i]) : "v"(vb), "i"(((i) >> 2) * 512 + ((i) & 3) * 4096 + 2048) : "memory"); } while (0)
#pragma unroll
          for (int i = 0; i < 7; ++i) DF_VRD(i);
          asm volatile("s_waitcnt lgkmcnt(14)" ::: "memory"); __builtin_amdgcn_sched_barrier(0);
#pragma unroll
          for (int d0 = 0; d0 < 4; ++d0) { p0 = __builtin_amdgcn_mfma_f32_32x32x16_bf16(kf[2 * d0], qr[d0], p0, 0, 0, 0); p1 = __builtin_amdgcn_mfma_f32_32x32x16_bf16(kf[2 * d0 + 1], qr[d0], p1, 0, 0, 0); }
#pragma unroll
          for (int i = 7; i < 16; ++i) DF_VRD(i);
#undef DF_VRD
        }
        softmax_tile(p0, p1, m_reg, l_reg, alpha, pa0, pa1, pa2, pa3);
        if (__any(alpha < 1.f)) { if (hi == 0) wsf[r32] = alpha; LDS_WAIT();
#pragma unroll
            for (int d = 0; d < 4; ++d)
#pragma unroll
                for (int r = 0; r < 16; ++r) o[d][r] *= wsf[crow(r, hi)]; }
        asm volatile("s_waitcnt lgkmcnt(0)" ::: "memory"); __builtin_amdgcn_sched_barrier(0);
#define DF_PK(i) (bf16x8){vl[i][0], vl[i][1], vl[i][2], vl[i][3], vh[i][0], vh[i][1], vh[i][2], vh[i][3]}
#pragma unroll
        for (int d0 = 0; d0 < 4; ++d0) {
            o[d0] = __builtin_amdgcn_mfma_f32_32x32x16_bf16(pa0, DF_PK(d0 * 4 + 0), o[d0], 0, 0, 0); o[d0] = __builtin_amdgcn_mfma_f32_32x32x16_bf16(pa1, DF_PK(d0 * 4 + 1), o[d0], 0, 0, 0);
            o[d0] = __builtin_amdgcn_mfma_f32_32x32x16_bf16(pa2, DF_PK(d0 * 4 + 2), o[d0], 0, 0, 0); o[d0] = __builtin_amdgcn_mfma_f32_32x32x16_bf16(pa3, DF_PK(d0 * 4 + 3), o[d0], 0, 0, 0); }
#undef DF_PK
        if (t + 1 < NT) { VM_WAIT(); DF_SWRITE(buf ^ 1); }
    }
#undef DF_SLOAD
#undef DF_SWRITE
    if (hi == 0) wsf[32 + r32] = l_reg; LDS_WAIT();
    float rli[16];
#pragma unroll
    for (int r = 0; r < 16; ++r) rli[r] = __builtin_amdgcn_rcpf(wsf[32 + crow(r, hi)]);
#pragma unroll
    for (int d = 0; d < 4; ++d)
#pragma unroll
        for (int r = 0; r < 16; ++r) o[d][r] *= rli[r];
    __syncthreads();
    LAS float* XO = (LAS float*)L + qsub * 4096;
    if (jh == 1) {
#pragma unroll
        for (int d = 0; d < 4; ++d)
#pragma unroll
            for (int r = 0; r < 16; ++r) XO[crow(r, hi) * 128 + d * 32 + r32] = o[d][r];
    }
    __syncthreads();
    if (jh == 0) {
        float ss[16];
#pragma unroll
        for (int r = 0; r < 16; ++r) { float s = 0.f;
#pragma unroll
            for (int d = 0; d < 4; ++d) { const float v = o[d][r] - lam * XO[crow(r, hi) * 128 + d * 32 + r32]; o[d][r] = v; s += v * v; }
            ss[r] = s; }
#pragma unroll
        for (int r = 0; r < 16; ++r) {
#pragma unroll
            for (int off = 1; off < 32; off <<= 1) ss[r] += __shfl_xor(ss[r], off);
            ss[r] = oscale / sqrtf(ss[r] * (1.f / 128.f) + EPS); }
        const int orow0 = (CTXQ ? NLAT + b * CTXL : b * SEQ) + qblk * 128 + qsub * 32;
#pragma unroll
        for (int d = 0; d < 4; ++d) { const float g = gain[d * 32 + r32];
#pragma unroll
            for (int r = 0; r < 16; ++r) CAT[(size_t)(orow0 + crow(r, hi)) * D + 256 + hd * 128 + d * 32 + r32] = (bf16_t)f2bf(o[d][r] * ss[r] * g); }
    }
    __syncthreads();
}

template <bool CTXQ>
__device__ __forceinline__ void diff_unit_fast(const Ctx& X0, const bf16_t* QKV, bf16_t* CAT, int b, int hd, int qblk, float lam, const float* gain, float oscale) {
    const Ctx X = fresh(X0);
    constexpr int K_OFF = 0, V_OFF = 4 * KT_BYTES  , WS_OFF = V_OFF + 2 * 16384  ;
    const int tid = X.tid, lane = X.lane, wid = X.wave, r32 = lane & 31, hi = lane >> 5, jh = wid >> 2, qsub = wid & 3;
    LAS char* L = (LAS char*)X.lds;
    LAS float* wsf = (LAS float*)(L + WS_OFF) + wid * 64;
    const int NT = CTXQ ? CTXL / 64 : KVR / 64;
    const int kbase = b * KVR;
    const int qrow = b * KVR + (CTXQ ? 0 : CTXL) + qblk * 128 + qsub * 32 + r32;
    bf16x8 qr[4];
#pragma unroll
    for (int d0 = 0; d0 < 4; ++d0) qr[d0] = *(const bf16x8*)(QKV + (size_t)qrow * INC + C_QB + (2 * hd + jh) * 64 + d0 * 16 + hi * 8);
    const int khh = tid >> 8, kr = (tid >> 3) & 31, kc = tid & 7;
    const bf16_t* kg = QKV + (size_t)(kbase + kr) * INC + C_KB + (2 * hd + khh) * 64 + kc * 8;
    const int kl = K_OFF + khh * KT_BYTES + kc * KCH + kr * 16;
    const int sr = tid >> 4, sc = (tid & 15) * 8;
    const bf16_t* vg_ = QKV + (size_t)(kbase + sr) * INC + C_VB + hd * 128 + sc; const bf16_t* vg = vg_;
    const int vl0 = V_OFF + v_st_nat<4>(sr, sc), vl1 = V_OFF + v_st_nat<4>(32 + sr, sc);
    const int vb0 = (int)(uintptr_t)X.ldsg + V_OFF + v_rd_base(lane);
    const int ka0 = (int)(uintptr_t)X.ldsg + K_OFF + jh * KT_BYTES + hi * KCH + r32 * 16;
    bf16x8 ks0, ks1, vs0, vs1;
#define DF_SLOAD(t) do { ks0 = *(const bf16x8*)(kg); ks1 = *(const bf16x8*)(kg + 32 * INC); vs0 = *(const bf16x8*)(vg); vs1 = *(const bf16x8*)(vg + 32 * INC); kg += 64 * INC; vg += 64 * INC; } while (0)
#define DF_SWRITE(buf) do { *(LAS bf16x8*)(L + kl + (buf) * 2 * KT_BYTES) = ks0; *(LAS bf16x8*)(L + kl + (buf) * 2 * KT_BYTES + 512) = ks1; \
        *(LAS bf16x8*)(L + vl0 + (buf) * 16384) = vs0; *(LAS bf16x8*)(L + vl1 + (buf) * 16384) = vs1; } while (0)
    float l_reg = 0.f; f32x16 o[4] = {};
    u32x4 negm_w = {0u, 0u, 0u, 0u}; const u32x4 ones_w = {hi == 0 ? 0x3F80u : 0u, 0u, 0u, 0u};
    LAS unsigned* flagp = (LAS unsigned*)(L + WS_OFF) + 8 * 64;
    if (tid == 0) *flagp = 0u;
    DF_SLOAD(0); VM_WAIT(); DF_SWRITE(0);
    __syncthreads();
    { f32x16 p0, p1; qkt64(p0, p1, L + K_OFF + jh * KT_BYTES, qr, r32, hi);
      float pmax = p0[0];
#pragma unroll
      for (int r = 1; r < 16; ++r) pmax = fmaxf(pmax, p0[r]);
#pragma unroll
      for (int r = 0; r < 16; ++r) pmax = fmaxf(pmax, p1[r]);
      { auto rr = __builtin_amdgcn_permlane32_swap(__float_as_uint(pmax), __float_as_uint(pmax), false, false); pmax = fmaxf(__uint_as_float(rr[0]), __uint_as_float(rr[1])); }
      negm_w.x = hi == 0 ? f2bf(-pmax) : 0u; }
    const bf16x8 negm_f = __builtin_bit_cast(bf16x8, negm_w), ones_f = __builtin_bit_cast(bf16x8, ones_w);
#pragma unroll 1
    for (int t = 0; t < NT; ++t) {
        const int buf = t & 1;
        __syncthreads();
        if (t + 1 < NT) DF_SLOAD(t + 1);
        bf16x8 pa0, pa1, pa2, pa3;
        bf16x8 kf[8]; s16x4 vl[16], vh[16]; f32x16 p0, p1;
        { const int ka = ka0 + buf * 2 * KT_BYTES, vb = vb0 + buf * 16384;
#pragma unroll
          for (int i = 0; i < 8; ++i) asm volatile("ds_read_b128 %0, %1 offset:%2" : "=&v"(kf[i]) : "v"(ka), "i"((i >> 1) * 2 * KCH + (i & 1) * 512) : "memory");
#define DF_VRD(i) do { asm volatile("ds_read_b64_tr_b16 %0, %1 offset:%2" : "=&v"(vl[i]) : "v"(vb), "i"(((i) >> 2) * 512 + ((i) & 3) * 4096) : "memory"); \
                       asm volatile("ds_read_b64_tr_b16 %0, %1 offset:%2" : "=&v"(vh[i]) : "v"(vb), "i"(((i) >> 2) * 512 + ((i) & 3) * 4096 + 2048) : "memory"); } while (0)
#pragma unroll
          for (int i = 0; i < 7; ++i) DF_VRD(i);
          { bf16x8 on_ = ones_f; asm volatile("" : "+v"(on_));
            p0 = __builtin_amdgcn_mfma_f32_32x32x16_bf16(on_, negm_f, (f32x16){}, 0, 0, 0); asm volatile("" : "+v"(on_)); p1 = __builtin_amdgcn_mfma_f32_32x32x16_bf16(on_, negm_f, (f32x16){}, 0, 0, 0); }
          __builtin_amdgcn_sched_barrier(0);
          asm volatile("s_waitcnt lgkmcnt(14)" ::: "memory"); __builtin_amdgcn_sched_barrier(0);
#pragma unroll
          for (int d0 = 0; d0 < 4; ++d0) { p0 = __builtin_amdgcn_mfma_f32_32x32x16_bf16(kf[2 * d0], qr[d0], p0, 0, 0, 0); p1 = __builtin_amdgcn_mfma_f32_32x32x16_bf16(kf[2 * d0 + 1], qr[d0], p1, 0, 0, 0); }
#pragma unroll
          for (int i = 7; i < 16; ++i) DF_VRD(i);
#undef DF_VRD
        }
        { float sa = 0.f, sb = 0.f, sc_ = 0.f, sd = 0.f;
#pragma unroll
          for (int r = 0; r < 16; r += 2) { p0[r] = __builtin_amdgcn_exp2f(p0[r]); p0[r + 1] = __builtin_amdgcn_exp2f(p0[r + 1]); sa += p0[r]; sb += p0[r + 1]; }
#pragma unroll
          for (int r = 0; r < 16; r += 2) { p1[r] = __builtin_amdgcn_exp2f(p1[r]); p1[r + 1] = __builtin_amdgcn_exp2f(p1[r + 1]); sc_ += p1[r]; sd += p1[r + 1]; }
          l_reg += (sa + sb) + (sc_ + sd); asm volatile("" : "+v"(l_reg)); }
#define ATT_PKN(P, BASE, OUT) do { u32x4 w; w.x = cvt_pk_bf16(P[BASE + 0], P[BASE + 1]); w.y = cvt_pk_bf16(P[BASE + 2], P[BASE + 3]); w.z = cvt_pk_bf16(P[BASE + 4], P[BASE + 5]); w.w = cvt_pk_bf16(P[BASE + 6], P[BASE + 7]); \
    OUT = __builtin_bit_cast(bf16x8, w); } while (0)
        ATT_PKN(p0, 0, pa0); ATT_PKN(p0, 8, pa1); ATT_PKN(p1, 0, pa2); ATT_PKN(p1, 8, pa3);
#undef ATT_PKN
        asm volatile("s_waitcnt lgkmcnt(0)" ::: "memory"); __builtin_amdgcn_sched_barrier(0);
#define DF_PK(i) (bf16x8){vl[i][0], vl[i][1], vl[i][2], vl[i][3], vh[i][0], vh[i][1], vh[i][2], vh[i][3]}
#pragma unroll
        for (int d0 = 0; d0 < 4; ++d0) {
            o[d0] = __builtin_amdgcn_mfma_f32_32x32x16_bf16(pa0, DF_PK(d0 * 4 + 0), o[d0], 0, 0, 0); o[d0] = __builtin_amdgcn_mfma_f32_32x32x16_bf16(pa1, DF_PK(d0 * 4 + 1), o[d0], 0, 0, 0);
            o[d0] = __builtin_amdgcn_mfma_f32_32x32x16_bf16(pa2, DF_PK(d0 * 4 + 2), o[d0], 0, 0, 0); o[d0] = __builtin_amdgcn_mfma_f32_32x32x16_bf16(pa3, DF_PK(d0 * 4 + 3), o[d0], 0, 0, 0); }
#undef DF_PK
        if (t + 1 < NT) { VM_WAIT(); DF_SWRITE(buf ^ 1); }
    }
#undef DF_SLOAD
#undef DF_SWRITE
    { auto rr = __builtin_amdgcn_permlane32_swap(__float_as_uint(l_reg), __float_as_uint(l_reg), false, false); l_reg = __uint_as_float(rr[0]) + __uint_as_float(rr[1]); }
    if (__any(!(l_reg < 1.0e30f)) && lane == 0) *flagp = 1u;
    if (hi == 0) wsf[32 + r32] = l_reg; LDS_WAIT();
    float rli[16];
#pragma unroll
    for (int r = 0; r < 16; ++r) rli[r] = __builtin_amdgcn_rcpf(wsf[32 + crow(r, hi)]);
#pragma unroll
    for (int d = 0; d < 4; ++d)
#pragma unroll
        for (int r = 0; r < 16; ++r) o[d][r] *= rli[r];
    __syncthreads();
    const bool redo = *flagp != 0u;
    LAS float* XO = (LAS float*)L + qsub * 4096;
    if (jh == 1) {
#pragma unroll
        for (int d = 0; d < 4; ++d)
#pragma unroll
            for (int r = 0; r < 16; ++r) XO[crow(r, hi) * 128 + d * 32 + r32] = o[d][r];
    }
    __syncthreads();
    if (jh == 0) {
        float ss[16];
#pragma unroll
        for (int r = 0; r < 16; ++r) { float s = 0.f;
#pragma unroll
            for (int d = 0; d < 4; ++d) { const float v = o[d][r] - lam * XO[crow(r, hi) * 128 + d * 32 + r32]; o[d][r] = v; s += v * v; }
            ss[r] = s; }
#pragma unroll
        for (int r = 0; r < 16; ++r) {
#pragma unroll
            for (int off = 1; off < 32; off <<= 1) ss[r] += __shfl_xor(ss[r], off);
            ss[r] = oscale / sqrtf(ss[r] * (1.f / 128.f) + EPS); }
        const int orow0 = (CTXQ ? NLAT + b * CTXL : b * SEQ) + qblk * 128 + qsub * 32;
#pragma unroll
        for (int d = 0; d < 4; ++d) { const float g = gain[d * 32 + r32];
#pragma unroll
            for (int r = 0; r < 16; ++r) CAT[(size_t)(orow0 + crow(r, hi)) * D + 256 + hd * 128 + d * 32 + r32] = (bf16_t)f2bf(o[d][r] * ss[r] * g); }
    }
    __syncthreads();
    if (redo) diff_unit_safe<CTXQ>(X0, QKV, CAT, b, hd, qblk, lam, gain, oscale);
}

template <bool CTXQ>
__device__ __forceinline__ void na_unit(const Ctx& X0, const bf16_t* QKV, bf16_t* CAT, const float* rpb  , int b, int h, int r0) {
    const Ctx X = fresh(X0);
    constexpr int K_OFF = 0, V_OFF = 16896, RPB_OFF = V_OFF + 2 * 8192  , WS_OFF = RPB_OFF + 2048;
    const int tid = X.tid, lane = X.lane, wid = X.wave, r32 = lane & 31, hi = lane >> 5;
    LAS char* L = (LAS char*)X.lds;
    LAS float* wsf = (LAS float*)(L + WS_OFF) + wid * 64;
    LAS float* rpbL = (LAS float*)(L + RPB_OFF);
    const int kbase = b * KVR;
    int kr_lo = 0, nlat = 0, r = 0, qc = 0, rs = 0, qrow, orow;
    if (CTXQ) { qrow = kbase + wid * 32 + r32; orow = NLAT + b * CTXL + wid * 32; }
    else {
        kr_lo = min(max(r0 - 4, 0), GROWS - 8); const int kr_hi = min(max(r0 + 3 - 4, 0), GROWS - 8) + 8; nlat = kr_hi - kr_lo;
        r = r0 + (wid >> 1); qc = 32 * (wid & 1) + r32; rs = min(max(r - 4, 0), GROWS - 8);
        qrow = kbase + CTXL + r * GRIDW + qc; orow = b * SEQ + r * GRIDW + 32 * (wid & 1);
        for (int i = tid; i < 15 * 31; i += NWAVES * 64) rpbL[i] = rpb[i] * LOG2E;
    }
    const int NT = nlat + CTXL / 64;
    bf16x8 qr[4];
#pragma unroll
    for (int d0 = 0; d0 < 4; ++d0) qr[d0] = *(const bf16x8*)(QKV + (size_t)qrow * INC + C_QA + h * 64 + d0 * 16 + hi * 8);
    const int srow = tid >> 3, sc8 = tid & 7;
    const bf16_t* kg = QKV + (size_t)kbase * INC + C_KA + h * 64 + sc8 * 8;
    const bf16_t* vg = QKV + (size_t)kbase * INC + C_VA + h * 64 + sc8 * 8;
    const int kl = K_OFF + sc8 * KCH + srow * 16, vl = V_OFF + v_st<2>(srow, sc8 * 8);
    const int vb0 = (int)(uintptr_t)X.ldsg + V_OFF + v_rd_base(lane);
    bf16x8 ks, vs;
#define NA_TROW(t) ((t) < nlat ? CTXL + (kr_lo + (t)) * GRIDW : ((t) - nlat) * 64)
#define NA_SLOAD(t) do { const size_t go = (size_t)(NA_TROW(t) + srow) * INC; ks = *(const bf16x8*)(kg + go); vs = *(const bf16x8*)(vg + go); } while (0)
#define NA_SWRITE(buf) do { *(LAS bf16x8*)(L + kl + (buf) * KT_BYTES) = ks; *(LAS bf16x8*)(L + vl + (buf) * 8192) = vs; } while (0)
    float m_reg = -1e30f, l_reg = 0.f; f32x16 o[2] = {};
    const int ws = min(max(qc - 8, 0), GRIDW - 16);
    NA_SLOAD(0); VM_WAIT(); NA_SWRITE(0);
    for (int t = 0; t < NT; ++t) {
        const int buf = t & 1;
        __syncthreads();
        if (t + 1 < NT) NA_SLOAD(t + 1);
        const bool lat_tile = t < nlat;
        const int drow = kr_lo + t - r + 7;
        const bool active = !lat_tile || (unsigned)(kr_lo + t - rs) < 8u;
        if (active) {
            f32x16 p0, p1; float alpha; bf16x8 pa0, pa1, pa2, pa3;
            qkt64(p0, p1, L + K_OFF + buf * KT_BYTES, qr, r32, hi);
            if (lat_tile) {
                const LAS float* bp = rpbL + drow * 31 + 15 - qc;
#pragma unroll
                for (int rr = 0; rr < 16; ++rr) { const int k0 = crow(rr, hi), k1 = k0 + 32;
                    const bool v0 = (unsigned)(k0 - ws) < 16u, v1 = (unsigned)(k1 - ws) < 16u;
                    const float b0 = bp[v0 ? k0 : qc], b1 = bp[v1 ? k1 : qc];
                    p0[rr] = v0 ? p0[rr] + b0 : -1e30f; p1[rr] = v1 ? p1[rr] + b1 : -1e30f; }
            }
            softmax_tile(p0, p1, m_reg, l_reg, alpha, pa0, pa1, pa2, pa3);
            if (__any(alpha < 1.f)) { if (hi == 0) wsf[r32] = alpha; LDS_WAIT();
#pragma unroll
                for (int d = 0; d < 2; ++d)
#pragma unroll
                    for (int rr = 0; rr < 16; ++rr) o[d][rr] *= wsf[crow(rr, hi)]; }
            const int vb = vb0 + buf * 8192;
            pv_one<0, 2>(o[0], vb, pa0, pa1, pa2, pa3); pv_one<1, 2>(o[1], vb, pa0, pa1, pa2, pa3);
        }
        if (t + 1 < NT) { VM_WAIT(); NA_SWRITE(buf ^ 1); }
    }
#undef NA_TROW
#undef NA_SLOAD
#undef NA_SWRITE
    if (hi == 0) wsf[32 + r32] = l_reg; LDS_WAIT();
#pragma unroll
    for (int rr = 0; rr < 16; ++rr) { const float rl = __builtin_amdgcn_rcpf(wsf[32 + crow(rr, hi)]);
#pragma unroll
        for (int d = 0; d < 2; ++d) CAT[(size_t)(orow + crow(rr, hi)) * D + h * 64 + d * 32 + r32] = (bf16_t)f2bf(o[d][rr] * rl); }
    __syncthreads();
}
}

__device__ __forceinline__ void moe_route_phase(const Ctx& X0, const float* xlat, const float* shift0, const float* scale0, const float* router_w, unsigned char* H8) {
    const Ctx X = fresh(X0);
    LAS float* WrT = (LAS float*)X.lds;
    LAS int* pe = (LAS int*)(X.lds + 32768);
    LAS int* psl = pe + 512;
    LAS int* lcnt = psl + 512;
    LAS int* gbase = lcnt + 8;
    int* tokl = (int*)(X.ws + WS_TOKL); unsigned* tinfo = (unsigned*)(X.ws + WS_TINFO);
    for (int i = X.tid; i < D * NEXP; i += NWAVES * 64) WrT[(i & 7) * D + (i >> 3)] = router_w[i];
    if (X.tid < 8) lcnt[X.tid] = 0;
    __syncthreads();
    const int gw = X.vcu * NWAVES + X.wave, NGW = X.G * NWAVES;
    int nr = 0;
    for (int m0 = gw; m0 < NLAT && nr < 32; m0 += 4 * NGW) {
        const int ml = m0 + 3 * NGW, v0 = m0 < SEQ ? 0 : 1;
        if (ml < NLAT && (ml < SEQ ? 0 : 1) == v0 && nr + 4 <= 32) {
            f32x4 xv[4][4], sh[4], sc[4]; float rs[4], lg[4][8];
#pragma unroll
            for (int r = 0; r < 4; ++r) { const GAS f32x4* xr = (const GAS f32x4*)(xlat + (size_t)(m0 + r * NGW) * D) + X.lane;
#pragma unroll
                for (int j = 0; j < 4; ++j) xv[r][j] = xr[64 * j]; }
            const f32x4* shp = (const f32x4*)(shift0 + (size_t)v0 * 6 * D) + X.lane; const f32x4* scp = (const f32x4*)(scale0 + (size_t)v0 * 6 * D) + X.lane;
#pragma unroll
            for (int j = 0; j < 4; ++j) { sh[j] = shp[64 * j]; sc[j] = scp[64 * j] + 1.f; }
#pragma unroll
            for (int r = 0; r < 4; ++r) { float s2 = 0.f;
#pragma unroll
                for (int j = 0; j < 4; ++j) s2 += (xv[r][j].x * xv[r][j].x + xv[r][j].y * xv[r][j].y) + (xv[r][j].z * xv[r][j].z + xv[r][j].w * xv[r][j].w);
                rs[r] = s2; }
#pragma unroll
            for (int r = 0; r < 4; ++r) { rs[r] = 1.f / sqrtf(wave_sum(rs[r]) * (1.f / D) + EPS);
#pragma unroll
                for (int e = 0; e < 8; ++e) lg[r][e] = 0.f; }
#pragma unroll
            for (int j = 0; j < 4; ++j) {
#pragma unroll
                for (int r = 0; r < 4; ++r) { xv[r][j] = xv[r][j] * rs[r] * sc[j] + sh[j];
                    ((GAS unsigned*)(H8 + (size_t)(m0 + r * NGW) * D) + X.lane)[64 * j] = pk_fp8x4(xv[r][j].x, xv[r][j].y, xv[r][j].z, xv[r][j].w); }
#pragma unroll
                for (int e = 0; e < 8; ++e) { const f32x4 wr = *(const LAS f32x4*)(WrT + e * D + 256 * j + 4 * X.lane);
#pragma unroll
                    for (int r = 0; r < 4; ++r) lg[r][e] += (xv[r][j].x * wr.x + xv[r][j].y * wr.y) + (xv[r][j].z * wr.z + xv[r][j].w * wr.w); } }
#pragma unroll
            for (int r = 0; r < 4; ++r) {
#pragma unroll
                for (int e = 0; e < 8; ++e) lg[r][e] = wave_sum(lg[r][e]); }
#pragma unroll
            for (int r = 0; r < 4; ++r) { const int m = m0 + r * NGW;
                int i1 = 0; float v1 = lg[r][0];
#pragma unroll
                for (int e = 1; e < 8; ++e) if (lg[r][e] > v1) { v1 = lg[r][e]; i1 = e; }
                int i2 = -1; float v2 = -3.0e38f;
#pragma unroll
                for (int e = 0; e < 8; ++e) if (e != i1 && lg[r][e] > v2) { v2 = lg[r][e]; i2 = e; }
                const float g1 = 1.f / (1.f + __expf(v2 - v1)), g2 = 1.f - g1;
                if (X.lane == 0) {
                    const int s1 = __hip_atomic_fetch_add(lcnt + i1, 1, __ATOMIC_RELAXED, __HIP_MEMORY_SCOPE_WORKGROUP);
                    const int s2_ = __hip_atomic_fetch_add(lcnt + i2, 1, __ATOMIC_RELAXED, __HIP_MEMORY_SCOPE_WORKGROUP);
                    const int pi = (X.wave * 32 + nr + r) * 2; pe[pi] = i1; pe[pi + 1] = i2; psl[pi] = s1; psl[pi + 1] = s2_;
                    unsigned* ti = tinfo + (size_t)m * 8; ti[4] = __float_as_uint(g1); ti[5] = __float_as_uint(g2);
                } }
            nr += 4;
        } else {
            for (int m = m0; m < NLAT && m <= ml && nr < 32; m += NGW, ++nr) {
                const int v = m < SEQ ? 0 : 1;
                const GAS f32x4* xr = (const GAS f32x4*)(xlat + (size_t)m * D) + X.lane;
                const f32x4* shp = (const f32x4*)(shift0 + (size_t)v * 6 * D) + X.lane; const f32x4* scp = (const f32x4*)(scale0 + (size_t)v * 6 * D) + X.lane;
                f32x4 xv[4]; float s2 = 0.f;
        #pragma unroll
                for (int j = 0; j < 4; ++j) { xv[j] = xr[64 * j]; s2 += (xv[j].x * xv[j].x + xv[j].y * xv[j].y) + (xv[j].z * xv[j].z + xv[j].w * xv[j].w); }
                const float rstd = 1.f / sqrtf(wave_sum(s2) * (1.f / D) + EPS);
                GAS unsigned* o4 = (GAS unsigned*)(H8 + (size_t)m * D) + X.lane;
                float lg[8];
        #pragma unroll
                for (int e = 0; e < 8; ++e) lg[e] = 0.f;
        #pragma unroll
                for (int j = 0; j < 4; ++j) { const f32x4 sh = shp[64 * j], sc = scp[64 * j]; const f32x4 h = xv[j] * rstd * (sc + 1.f) + sh;
                    o4[64 * j] = pk_fp8x4(h.x, h.y, h.z, h.w);
        #pragma unroll
                    for (int e = 0; e < 8; ++e) { const f32x4 wr = *(const LAS f32x4*)(WrT + e * D + 256 * j + 4 * X.lane); lg[e] += (h.x * wr.x + h.y * wr.y) + (h.z * wr.z + h.w * wr.w); } }
        #pragma unroll
                for (int e = 0; e < 8; ++e) lg[e] = wave_sum(lg[e]);
                int i1 = 0; float v1 = lg[0];
        #pragma unroll
                for (int e = 1; e < 8; ++e) if (lg[e] > v1) { v1 = lg[e]; i1 = e; }
                int i2 = -1; float v2 = -3.0e38f;
        #pragma unroll
                for (int e = 0; e < 8; ++e) if (e != i1 && lg[e] > v2) { v2 = lg[e]; i2 = e; }
                const float g1 = 1.f / (1.f + __expf(v2 - v1)), g2 = 1.f - g1;
                if (X.lane == 0) {
                    const int s1 = __hip_atomic_fetch_add(lcnt + i1, 1, __ATOMIC_RELAXED, __HIP_MEMORY_SCOPE_WORKGROUP);
                    const int s2_ = __hip_atomic_fetch_add(lcnt + i2, 1, __ATOMIC_RELAXED, __HIP_MEMORY_SCOPE_WORKGROUP);
                    const int pi = (X.wave * 32 + nr) * 2; pe[pi] = i1; pe[pi + 1] = i2; psl[pi] = s1; psl[pi + 1] = s2_;
                    unsigned* ti = tinfo + (size_t)m * 8; ti[4] = __float_as_uint(g1); ti[5] = __float_as_uint(g2);
                }
            }
        }
    }
    __syncthreads();
    if (X.tid < 8) gbase[X.tid] = (int)__hip_atomic_fetch_add((unsigned*)(X.ctl + CW_ECNT + 64 * X.tid), (unsigned)lcnt[X.tid], RLX_AGENT);
    __syncthreads();
    if (X.lane < 2 * nr) {
        const int i = X.lane >> 1, k = X.lane & 1, pi = (X.wave * 32 + i) * 2 + k, m = gw + i * NGW;
        const int e = pe[pi], slot = gbase[e] + psl[pi];
        tokl[e * 16384 + slot] = m;
        unsigned* ti = tinfo + (size_t)m * 8; ti[2 * k] = (unsigned)e; ti[2 * k + 1] = (unsigned)slot;
    }
    __syncthreads();
}
__device__ __forceinline__ int moe_setup(const Ctx& X0) {
    const Ctx X = fresh(X0);
    if (X.tid == 0) { unsigned pre = 0;
        for (int e = 0; e < NEXP; ++e) { unsigned c = __hip_atomic_load((unsigned*)(X.ctl + CW_ECNT + 64 * e), RLX_AGENT); if (c > 16384u) c = 16384u; X.MISC[16 + e] = pre; X.MISC[32 + e] = c; pre += (c + 255u) >> 8; }
        X.MISC[16 + NEXP] = pre > (unsigned)MOE_MAXP ? (unsigned)MOE_MAXP : pre; }
    __syncthreads();
    return (int)X.MISC[16 + NEXP];
}
__device__ __forceinline__ void final_phase(const Ctx& X0, float* xlat, const bf16_t* Y, const float* gf0, const float* fgain) {
    const Ctx X = fresh(X0);
    const unsigned* tinfo = (const unsigned*)(X.ws + WS_TINFO);
    const bf16_t* Yt = (const bf16_t*)(X.ws + WS_YT);
    const int gw = X.vcu * NWAVES + X.wave, NGW = X.G * NWAVES;
#define FY_UNPK(w_) ((f32x4){__uint_as_float((w_).x << 16), __uint_as_float((w_).x & 0xffff0000u), __uint_as_float((w_).y << 16), __uint_as_float((w_).y & 0xffff0000u)})
#define FY_LOAD(dst_, y_) do { const size_t yy_ = (y_); \
        if (yy_ < 32768) { _Pragma("unroll") for (int j = 0; j < 4; ++j) { const u32x2 w = ((const u32x2*)(Y + yy_ * D) + X.lane)[64 * j]; dst_[j] = FY_UNPK(w); } } \
        else { _Pragma("unroll") for (int j = 0; j < 4; ++j) { dst_[j] = (f32x4){0.f, 0.f, 0.f, 0.f}; \
            _Pragma("unroll") for (int sl = 0; sl < 7; ++sl) { const u32x2 w = ((const u32x2*)(Yt + ((size_t)sl * 2048 + (yy_ - 32768)) * D) + X.lane)[64 * j]; dst_[j] += FY_UNPK(w); } } } } while (0)
    const f32x4* fg = (const f32x4*)fgain + X.lane;
    for (int m0 = gw; m0 < NLAT; m0 += 2 * NGW) {
        const int nrow = m0 + NGW < NLAT ? 2 : 1;
        if (nrow == 2) {
            unsigned t[2][6]; f32x4 xv[2][4], gp[2][4], ya[2][4], yb[2][4];
#pragma unroll
            for (int r = 0; r < 2; ++r) { const unsigned* ti = tinfo + (size_t)(m0 + r * NGW) * 8;
#pragma unroll
                for (int k = 0; k < 6; ++k) t[r][k] = ti[k]; }
#pragma unroll
            for (int r = 0; r < 2; ++r) { const int m = m0 + r * NGW; const GAS f32x4* xr = (const GAS f32x4*)(xlat + (size_t)m * D) + X.lane;
                const f32x4* gpp = (const f32x4*)(gf0 + (size_t)(m < SEQ ? 0 : 1) * 6 * D) + X.lane;
#pragma unroll
                for (int j = 0; j < 4; ++j) { xv[r][j] = xr[64 * j]; gp[r][j] = gpp[64 * j]; } }
#pragma unroll
            for (int r = 0; r < 2; ++r) {
                const size_t y1 = (size_t)((int)X.MISC[16 + (int)t[r][0]] * 256 + (int)t[r][1]), y2 = (size_t)((int)X.MISC[16 + (int)t[r][2]] * 256 + (int)t[r][3]);
                FY_LOAD(ya[r], y1); FY_LOAD(yb[r], y2); }
            float ss[2];
#pragma unroll
            for (int r = 0; r < 2; ++r) { const float g1 = __uint_as_float(t[r][4]), g2 = __uint_as_float(t[r][5]); ss[r] = 0.f;
#pragma unroll
                for (int j = 0; j < 4; ++j) { xv[r][j] = xv[r][j] + gp[r][j] * (ya[r][j] * g1 + yb[r][j] * g2); ss[r] += (xv[r][j].x * xv[r][j].x + xv[r][j].y * xv[r][j].y) + (xv[r][j].z * xv[r][j].z + xv[r][j].w * xv[r][j].w); } }
#pragma unroll
            for (int r = 0; r < 2; ++r) ss[r] = 1.f / sqrtf(wave_sum(ss[r]) * (1.f / D) + EPS);
#pragma unroll
            for (int r = 0; r < 2; ++r) { GAS f32x4* xw = (GAS f32x4*)(xlat + (size_t)(m0 + r * NGW) * D) + X.lane;
#pragma unroll
                for (int j = 0; j < 4; ++j) xw[64 * j] = xv[r][j] * ss[r] * fg[64 * j]; }
        } else {
            const int m = m0; const int v = m < SEQ ? 0 : 1;
            const unsigned* ti = tinfo + (size_t)m * 8;
            const int e1 = (int)ti[0], s1 = (int)ti[1], e2 = (int)ti[2], s2 = (int)ti[3]; const float g1 = __uint_as_float(ti[4]), g2 = __uint_as_float(ti[5]);
            const size_t y1 = (size_t)((int)X.MISC[16 + e1] * 256 + s1), y2 = (size_t)((int)X.MISC[16 + e2] * 256 + s2);
            GAS f32x4* xr = (GAS f32x4*)(xlat + (size_t)m * D) + X.lane;
            f32x4 ya[4], yb[4];
            FY_LOAD(ya, y1); FY_LOAD(yb, y2);
            const f32x4* gp = (const f32x4*)(gf0 + (size_t)v * 6 * D) + X.lane;
            f32x4 xv[4]; float ss = 0.f;
#pragma unroll
            for (int j = 0; j < 4; ++j) { xv[j] = xr[64 * j] + gp[64 * j] * (ya[j] * g1 + yb[j] * g2); ss += (xv[j].x * xv[j].x + xv[j].y * xv[j].y) + (xv[j].z * xv[j].z + xv[j].w * xv[j].w); }
            const float rstd = 1.f / sqrtf(wave_sum(ss) * (1.f / D) + EPS);
#pragma unroll
            for (int j = 0; j < 4; ++j) xr[64 * j] = xv[j] * rstd * fg[64 * j];
        }
    }
#undef FY_LOAD
#undef FY_UNPK
}

constexpr int N_PHASES = 16;
constexpr int N_LAUNCHES = MK_N_LAUNCHES;
__global__ void __launch_bounds__(NWAVES * 64, 2) fwd(Params P) {
    extern __shared__ __attribute__((aligned(16))) unsigned char lds[];
    Ctx X;
    X.lds = (LAS unsigned char*)lds; X.ldsg = (char*)lds;
    X.MISC = (volatile LAS unsigned*)(X.lds + MISC_OFF);
    X.tid = threadIdx.x; X.lane = X.tid & 63; X.wave = __builtin_amdgcn_readfirstlane(X.tid >> 6);
    X.G = gridDim.x; { const int bx = blockIdx.x; X.vcu = (X.G % 8 == 0) ? (bx % 8) * (X.G / 8) + bx / 8 : bx; }
    X.ws = P.ws; X.ctl = (gu32*)(P.ws + WS_CTL);
    for (int u = X.tid; u < (LDS_BYTES - RING_BYTES) / 4; u += NWAVES * 64) ((LAS unsigned*)(X.lds + RING_BYTES))[u] = 0u;
    __syncthreads();
    XcdBarrier bar; bar.bar = (unsigned*)(X.ctl + CW_BAR); bar.x = 0; bar.st = nullptr;
    if (N_LAUNCHES != N_PHASES) bar = xcd_barrier_post((unsigned*)(X.ctl + CW_BAR), X.MISC + 8);
#define GRID_BAR() do { if (N_LAUNCHES == N_PHASES) { if (X.tid == 0) __hip_atomic_store(X.ctl + CW_TMO, 0xBADBA0u, RLX_AGENT); } else { xcd_barrier(bar); } } while (0)
    const int lo = P.ph_lo, hi = P.ph_hi;
#ifndef PH_MASK
#define PH_MASK 0xFFFF
#endif
#define IN(k) (((PH_MASK >> (k)) & 1) && lo <= (k) && (k) < hi)
#ifndef REP_MASK
#define REP_MASK 0
#endif
#define REPS(k) (((REP_MASK >> (k)) & 1) ? 2 : 1)
#define BOTH(k) (IN(k) && IN((k) + 1))
#define LIN(j) (((PH_MASK >> (1 + (j))) & 1) && lo <= (pb + (j)) && (pb + (j)) < hi)
#define LBOTH(j) (LIN(j) && lo <= (pb + (j) + 1) && (pb + (j) + 1) < hi)
    unsigned char* ws = P.ws;
    bf16_t* H = (bf16_t*)(ws + WS_H); bf16_t* QKV = (bf16_t*)(ws + WS_QKV); bf16_t* CAT = (bf16_t*)(ws + WS_CAT); bf16_t* HID = (bf16_t*)(ws + WS_HID);
    float* XCTX = (float*)(ws + WS_XCTX);

    if (IN(0)) { for (int rep = 0; rep < REPS(0); ++rep) { p0_prologue(X, P); if (rep + 1 < REPS(0)) GRID_BAR(); } if (BOTH(0)) GRID_BAR(); }

    for (int Lr = 0; Lr < 2; ++Lr) {
        const int L = __builtin_amdgcn_readfirstlane(Lr);
        const int pb = 1 + 7 * L;
        const float* xl = L == 0 ? P.x : P.out; const float* xc = L == 0 ? P.ctx : XCTX;
        if (LIN(0)) { norm_phase(X, xl, xc, modp(X, L, 0, 0), modp(X, L, 0, 1), H, MROWS); if (LBOTH(0)) GRID_BAR(); }
        if (LIN(1)) {
            SchedPlain S; S.T.init(NLAT / 256, INC / 256, X.G, (int)blockIdx.x); S.Bt = (const char*)(ws + WS_WIN) + (size_t)L * INC * D * 2; S.K = D;
            EpiInProj E{QKV, (const f32x2*)(ws + WS_TABR), (const f32x2*)(ws + WS_TABC)};
            { const int co = L == 0 ? 0 : C_KA;
              thin_gemm(X, H + (size_t)NLAT * D, (const bf16_t*)(ws + WS_WIN) + (size_t)L * INC * D + (size_t)co * D, L == 0 ? INC : C_XIN - C_KA, D, ThinInProj{QKV, co}, X.vcu, X.G); }
            for (int rep = 0; rep < REPS(2); ++rep) { pg8::gemm_phase<EpiInProj, SchedPlain, true>(X.lds, (const char*)H, D, S, E); if (rep + 1 < REPS(2)) GRID_BAR(); }
            if (LBOTH(1)) GRID_BAR();
        }
        if (LIN(2)) {
            for (int rep = 0; rep < REPS(3); ++rep) {
            const float lam = ((const float*)(ws + WS_LAM))[L]; const float oscale = L == 0 ? 0.8f : (1.f - (0.8f - 0.6f * 0.74081822068171786607f));
            const float* gain = P.diff_subln + L * 128;
            for (int u = X.vcu; u < 512; u += X.G) { const int bh = (u & 255) >> 5, qblk = (u & 31) + 32 * (u >> 8); att::diff_unit_fast<false>(X, QKV, CAT, bh >> 2, bh & 3, qblk, lam, gain, oscale); }
            for (int u = X.vcu; u < 256; u += X.G) { const int b = u >> 7, h = (u >> 5) & 3, r0 = (u & 31) * 4; att::na_unit<false>(X, QKV, CAT, P.na_rpb + (L * 4 + h) * 465, b, h, r0); }
            if (L == 0) {
                for (int u = X.vcu; u < 16; u += X.G) att::diff_unit_fast<true>(X, QKV, CAT, u >> 3, (u >> 1) & 3, u & 1, lam, gain, oscale);
                for (int u = X.vcu - 16; u < 8; u += X.G) if (u >= 0) att::na_unit<true>(X, QKV, CAT, nullptr, u >> 2, u & 3, 0);
            }
            conv_phase(X, QKV, CAT, P.conv_w + L * 768, L == 0 ? MROWS : NLAT);
            if (rep + 1 < REPS(3)) GRID_BAR(); }
            if (LBOTH(2)) GRID_BAR();
        }
        if (LIN(3)) {
            SchedPlain S; S.T.init(NLAT / 256, D / 256, X.G, (int)blockIdx.x); S.Bt = (const char*)(ws + WS_WOUT) + (size_t)L * D * D * 2; S.K = D;
            EpiResGate E{xl, xc, P.out, XCTX, modp(X, L, 0, 2)};
            if (L == 0) thin_gemm(X, CAT + (size_t)NLAT * D, (const bf16_t*)(ws + WS_WOUT), D, D, ThinResGate{P.ctx, XCTX, modp(X, 0, 2, 2)}, X.vcu, X.G);
            pg8::gemm_phase<EpiResGate, SchedPlain, true>(X.lds, (const char*)CAT, D, S, E);
            if (LBOTH(3)) GRID_BAR();
        }
        if (L == 0) {
            if (IN(5)) { norm_phase(X, P.out, XCTX, modp(X, 0, 0, 3), modp(X, 0, 0, 4), H, MROWS); if (BOTH(5)) GRID_BAR(); }
            if (IN(6)) {
                SchedPlain S; S.T.init(NLAT / 256, 2 * DFF / 256, X.G, (int)blockIdx.x); S.Bt = (const char*)(ws + WS_W13); S.K = D;
                EpiSwiGLU E{HID, DFF};
                for (int rep = 0; rep < REPS(6); ++rep) { pg8::gemm_phase<EpiSwiGLU, SchedPlain, true>(X.lds, (const char*)H, D, S, E); if (rep + 1 < REPS(6)) GRID_BAR(); }
                { const int nun = (NLAT / 256) * (2 * DFF / 256), nshort = X.G - nun % X.G, b0 = (int)blockIdx.x - nun % X.G;
                  if (nun % X.G == 0) thin_gemm(X, H + (size_t)NLAT * D, (const bf16_t*)(ws + WS_W13), 2 * DFF, D, ThinSwiGLU{HID + (size_t)NLAT * DFF, DFF}, X.vcu, X.G);
                  else if (b0 >= 0) thin_gemm(X, H + (size_t)NLAT * D, (const bf16_t*)(ws + WS_W13), 2 * DFF, D, ThinSwiGLU{HID + (size_t)NLAT * DFF, DFF}, b0, nshort); }
                if (BOTH(6)) GRID_BAR();
            }
            if (IN(7)) {
                SchedPlain S; S.T.init(NLAT / 256, D / 256, X.G, (int)blockIdx.x); S.Bt = (const char*)(ws + WS_W2); S.K = DFF;
                EpiResGate E{P.out, XCTX, P.out, XCTX, modp(X, 0, 0, 5)};
                thin_gemm(X, HID + (size_t)NLAT * DFF, (const bf16_t*)(ws + WS_W2), D, DFF, ThinResGate{XCTX, XCTX, modp(X, 0, 2, 5)}, X.vcu, X.G);
                pg8::gemm_phase<EpiResGate, SchedPlain, true>(X.lds, (const char*)HID, DFF, S, E);
                if (BOTH(7)) GRID_BAR();
            }
        }
    }
    if (IN(12)) { moe_route_phase(X, P.out, modp(X, 1, 0, 3), modp(X, 1, 0, 4), P.router_w, (unsigned char*)H); if (BOTH(12)) GRID_BAR(); }
    if (IN(13)) {
        const int NP = moe_setup(X);
        SchedMoe<true> S; S.T.init(NP, 2 * DEXP / 256, X.G, (int)blockIdx.x); S.Bt = (const char*)(ws + WS_MW13); S.K = D / 2; S.estride = (size_t)2 * DEXP * D; S.M = X.MISC; S.tokl = (const int*)(ws + WS_TOKL);
        EpiSwiGLU8 E{ws + WS_MHID, DEXP};
        for (int rep = 0; rep < REPS(13); ++rep) { pg8::gemm_phase<EpiSwiGLU8, SchedMoe<true>, true, true>(X.lds, (const char*)H, D / 2, S, E); if (rep + 1 < REPS(13)) GRID_BAR(); }
        if (BOTH(13)) GRID_BAR();
    }
    if (IN(14)) {
        const int NP = moe_setup(X);
        SchedMoe<false> S; S.T.init(NP < 128 ? NP : 128, D / 256, X.G, (int)blockIdx.x); S.Bt = (const char*)(ws + WS_MW2); S.K = DEXP / 2; S.estride = (size_t)D * DEXP; S.M = X.MISC; S.tokl = nullptr;
        EpiStoreBf16 E{(bf16_t*)(ws + WS_Y), 1.f / MOE_W2_SCALE};
        for (int rep = 0; rep < REPS(14); ++rep) { pg8::gemm_phase<EpiStoreBf16, SchedMoe<false>, true, true>(X.lds, (const char*)(ws + WS_MHID), DEXP / 2, S, E); if (rep + 1 < REPS(14)) GRID_BAR(); }
        if (NP > 128) {
            SchedMoeTail St; St.first = (int)blockIdx.x; St.count = (NP - 128) * 4 * 7; St.Bt = (const char*)(ws + WS_MW2); St.K = DEXP / 2; St.estride = (size_t)D * DEXP; St.M = X.MISC;
            EpiTailPart Et{(bf16_t*)(ws + WS_YT), 1.f / MOE_W2_SCALE};
            pg8::gemm_phase<EpiTailPart, SchedMoeTail, true, true>(X.lds, (const char*)(ws + WS_MHID), DEXP / 2, St, Et, 256);
        }
        if (BOTH(14)) GRID_BAR();
    }
    if (IN(15)) { (void)moe_setup(X); final_phase(X, P.out, (const bf16_t*)(ws + WS_Y), modp(X, 1, 0, 5), P.final_gain); }
#undef IN
#undef LIN
#undef LBOTH
#undef BOTH
#undef GRID_BAR
}

extern "C" void kernel_launch(void* const* d_in, const int* in_sizes, int n_in, void* d_out, int out_size, void* d_ws, size_t ws_size, hipStream_t stream) {
    static int grid = 0;
    if (grid == 0) {
        if (n_in != 20 || in_sizes[0] != NLAT * D || out_size != NLAT * D || ws_size < WS_END) { fprintf(stderr, "kernel_launch: unexpected shapes (n_in %d, in0 %d, out %d, ws %zu < %zu)\n", n_in, n_in > 0 ? in_sizes[0] : -1, out_size, ws_size, (size_t)WS_END); grid = -1; return; }
        int dev = 0, cus = 0, per_cu = 0;
        if (hipGetDevice(&dev) != hipSuccess || hipDeviceGetAttribute(&cus, hipDeviceAttributeMultiprocessorCount, dev) != hipSuccess) { grid = -1; return; }
        if (hipFuncSetAttribute((const void*)fwd, hipFuncAttributeMaxDynamicSharedMemorySize, LDS_BYTES) != hipSuccess) { fprintf(stderr, "kernel_launch: hipFuncSetAttribute failed\n"); grid = -1; return; }
        if (hipOccupancyMaxActiveBlocksPerMultiprocessor(&per_cu, (const void*)fwd, NWAVES * 64, LDS_BYTES) != hipSuccess || per_cu < 1) { fprintf(stderr, "kernel_launch: occupancy query says %d blocks per CU\n", per_cu); }
        (void)hipGetLastError();
        grid = cus;
    }
    if (grid < 0) return;
    if (hipMemsetAsync((char*)d_ws + WS_CTL, 0, CTL_ZERO_BYTES, stream) != hipSuccess) return;
    Params p{};
    const float** pp = (const float**)&p;
    for (int i = 0; i < 20; ++i) pp[i] = (const float*)d_in[i];
    p.out = (float*)d_out; p.ws = (unsigned char*)d_ws;
    for (int li = 0; li < N_LAUNCHES; ++li) {
        p.ph_lo = (N_LAUNCHES == N_PHASES) ? li : 0; p.ph_hi = (N_LAUNCHES == N_PHASES) ? li + 1 : N_PHASES; p.li = li; p.pad = 0;
        hipLaunchKernelGGL(fwd, dim3(grid), dim3(NWAVES * 64), LDS_BYTES, stream, p);
    }
}
```

```cpp
#include <hip/hip_runtime.h>
#include <cstdio>
#include <cstdint>

#define LAS __attribute__((address_space(3)))
#define GAS __attribute__((address_space(1)))
typedef unsigned short bf16_t;
typedef short bf16x8 __attribute__((ext_vector_type(8)));
typedef short s16x4 __attribute__((ext_vector_type(4)));
typedef float f32x2 __attribute__((ext_vector_type(2)));
typedef float f32x4 __attribute__((ext_vector_type(4)));
typedef float f32x16 __attribute__((ext_vector_type(16)));
typedef unsigned u32x2 __attribute__((ext_vector_type(2)));
typedef unsigned u32x4 __attribute__((ext_vector_type(4)));
typedef GAS unsigned gu32;
typedef __bf16 bf16x2_t __attribute__((ext_vector_type(2)));

#ifndef MK_N_LAUNCHES
#define MK_N_LAUNCHES 1
#endif

constexpr int D = 1024, BATCH = 2, SEQ = 8192, NLAT = BATCH * SEQ, CTXL = 256, NCTX = BATCH * CTXL, MROWS = NLAT + NCTX;
constexpr int GRIDW = 64, GROWS = SEQ / GRIDW;
constexpr int INC = 3072, DFF = 2816, DEXP = 3584, NEXP = 8;
constexpr int KVR = CTXL + SEQ;
constexpr int QKVROWS = BATCH * KVR;
constexpr int C_QA = 0, C_QB = 256, C_KA = 768, C_KB = 1024, C_VA = 1536, C_VB = 1792, C_XIN = 2304, C_BG = 2560, C_CG = 2816;
constexpr float EPS = 1e-6f;
constexpr float LOG2E = 1.4426950408889634f;
constexpr float C2 = 0.125f * LOG2E;
constexpr int MOE_MAXP = 136;

constexpr size_t MiB = 1u << 20;
constexpr size_t WS_CTL = 0, CTL_ZERO_BYTES = 1 * MiB;
constexpr size_t WS_MODS = 1 * MiB;
constexpr size_t WS_TABR = WS_MODS + 2 * 3 * 6144 * 4;
constexpr size_t WS_TABC = WS_TABR + 128 * 16 * 8;
constexpr size_t WS_LAM = WS_TABC + 64 * 16 * 8;
constexpr size_t WS_TOKL = 2 * MiB;
constexpr size_t WS_GATL = WS_TOKL + 8 * 16384 * 4;
constexpr size_t WS_TINFO = 3 * MiB;
constexpr size_t WS_XCTX = 4 * MiB;
constexpr size_t WS_MW2 = 6 * MiB;
constexpr size_t WS_MW13 = 62 * MiB;
constexpr size_t WS_H = 174 * MiB;
constexpr size_t WS_Y = 62 * MiB;
constexpr size_t WS_ARENA = 207 * MiB;
constexpr size_t WS_WIN = WS_ARENA;
constexpr size_t WS_WOUT = WS_WIN + 12 * MiB;
constexpr size_t WS_W13 = WS_WOUT + 4 * MiB;
constexpr size_t WS_W2 = WS_W13 + 11 * MiB;
constexpr size_t WS_QKV = WS_W2 + 6 * MiB;
constexpr size_t WS_CAT = WS_QKV + 99 * MiB;
constexpr size_t WS_HID = WS_CAT + 33 * MiB;
constexpr size_t WS_MHID = WS_ARENA;
constexpr size_t WS_YT = WS_ARENA + 238 * MiB;
constexpr size_t WS_END = WS_YT + 28 * MiB;
static_assert(WS_YT >= WS_MHID + (size_t)MOE_MAXP * 256 * DEXP * 2, "tail partials behind the MoE hidden buffer");
static_assert(WS_Y + (size_t)MOE_MAXP * 256 * D * 4 <= WS_ARENA, "Y overlay");
static_assert(WS_MHID + (size_t)MOE_MAXP * 256 * DEXP * 2 <= WS_END, "MoE hidden overlay");
static_assert(WS_TINFO + (size_t)NLAT * 32 <= WS_XCTX && WS_LAM + 64 <= WS_TOKL, "map");
constexpr int CW_TMO = 0, CW_CODE = 1, CW_BAR = 4096, CW_ECNT = 16384, CW_MIXQ = 20480;

constexpr int RING_BYTES = 131072;
constexpr int MISC_OFF = RING_BYTES + 320;
constexpr int LDS_BYTES = 147456;
constexpr int NWAVES = 8;

__device__ __forceinline__ unsigned cvt_pk_bf16(float lo, float hi) { unsigned r; asm volatile("v_cvt_pk_bf16_f32 %0, %1, %2" : "=v"(r) : "v"(lo), "v"(hi)); return r; }
__device__ __forceinline__ unsigned pk_fp8x4(float a, float b, float c, float d) { int w = 0; w = __builtin_amdgcn_cvt_pk_fp8_f32(a, b, w, false); w = __builtin_amdgcn_cvt_pk_fp8_f32(c, d, w, true); return (unsigned)w; }
constexpr float MOE_W13_SCALE = 32.f, MOE_W2_SCALE = 64.f;
__device__ __forceinline__ float bf2f(unsigned short b) { return __builtin_bit_cast(float, (unsigned)b << 16); }
__device__ __forceinline__ float wave_sum(float v) {
#pragma unroll
    for (int o = 1; o < 64; o <<= 1) v += __shfl_xor(v, o);
    return v;
}
__device__ __forceinline__ int fresh_tid() { int t = threadIdx.x; asm volatile("" : "+v"(t)); return t; }
__device__ __forceinline__ void st16_wt(void* p, u32x4 v) { asm volatile("global_store_dwordx4 %0, %1, off sc0 sc1\n\ts_nop 1" :: "v"(p), "v"(v) : "memory"); }
__device__ __forceinline__ void st8_wt(void* p, u32x2 v) { asm volatile("global_store_dwordx2 %0, %1, off sc0 sc1\n\ts_nop 1" :: "v"(p), "v"(v) : "memory"); }
#define LDS_WAIT() asm volatile("s_waitcnt lgkmcnt(0)" ::: "memory")
#define VM_WAIT() asm volatile("s_waitcnt vmcnt(0)" ::: "memory")
#define RLX_AGENT __ATOMIC_RELAXED, __HIP_MEMORY_SCOPE_AGENT

namespace pg8 {
constexpr int BM = 256, BK = 64, HALF = 128, HTB = HALF * BK * 2, STAGE_BYTES = 8 * HTB, NXCD = 8, WGM = 8;
__host__ __device__ __forceinline__ int lds_byte(int r, int c) { const int st = (r >> 4) * 2 + (c >> 5), rr = r & 15, cc = c & 31, ob = rr * 64 + cc * 2; return st * 1024 + (ob ^ (((ob >> 9) & 1) << 5)); }
__host__ __device__ __forceinline__ void stage_rc(int b, int& R, int& C) { const int st = b / 1024, sb = b % 1024, swz = sb ^ (((sb >> 9) & 1) << 5); R = (st >> 1) * 16 + swz / 64; C = (st & 1) * 32 + (swz % 64) / 2; }
__host__ __device__ __forceinline__ int perm32(int rho) { const int n = rho >> 4, i = rho & 15; return 8 * (i >> 2) + 4 * n + (i & 3); }

struct Unit { int pm, pn, e, pl; };

struct TileOrder {
    int nM, nN, nwg, G, c;
    __device__ __forceinline__ void init(int nM_, int nN_, int G_, int c_) { nM = nM_; nN = nN_; nwg = nM * nN; G = G_; c = c_; }
    __device__ __forceinline__ bool tile(int i, int& pm, int& pn) const {
        const long L = (long)i * G + c; if (L >= nwg) return false;
        int wgid = (int)L; { const int q = nwg / NXCD, r = nwg % NXCD, xcd = wgid % NXCD, off = wgid / NXCD; wgid = (xcd < r ? xcd * (q + 1) : r * (q + 1) + (xcd - r) * q) + off; }
        const int nig = WGM * nN, gid = wgid / nig, fm = gid * WGM, gsz = (nM - fm) < WGM ? (nM - fm) : WGM;
        pm = fm + ((wgid % nig) % gsz); pn = (wgid % nig) / gsz; return true;
    }
};

template <class Epi, class Sched, bool ALIGN_EPI, bool F8 = false>
__device__ __forceinline__ void gemm_phase(LAS unsigned char* lds, const char* Abase, const int K, const Sched& S, const Epi& E, const int Klen = 0) {
    const int tid = fresh_tid(), wid = __builtin_amdgcn_readfirstlane(tid >> 6), lane = tid & 63, wr = wid >> 2, wc = wid & 3, fr = lane & 15, fq = lane >> 4;
    const int nt = (Klen ? Klen : K) / BK;
    int Rr[2], Cc[2]; unsigned voffB[2];
#pragma unroll
    for (int i = 0; i < 2; ++i) { int R, C; stage_rc(tid * 16 + i * 8192, R, C); const int Rb = Epi::PERM ? ((R & ~31) + perm32(R & 31)) : R; Rr[i] = R; Cc[i] = C; voffB[i] = (unsigned)(Rb * K + C) * 2u; }
    const size_t kstep = (size_t)(BK * 2);
    const size_t hstep = (size_t)HALF * K * 2;
    const unsigned ldsw = (unsigned)wid * 1024u;
    const int aoff = lds_byte(wr * 64 + fr, fq * 8), boff = lds_byte(wc * 32 + fr, fq * 8);
#define PG8_SA(b, h) (((b) * 2 + (h)) * HTB)
#define PG8_SB(b, h) ((4 + (b) * 2 + (h)) * HTB)
#define PG8_STAGE(bufoff, gbase, voff) do { _Pragma("unroll") for (int _i = 0; _i < 2; ++_i) \
        __builtin_amdgcn_global_load_lds((const unsigned*)((const char*)(gbase) + (voff)[_i]), (LAS unsigned*)(lds + (bufoff) + ldsw + _i * 8192), 16, 0, 0); } while (0)
    typedef int v4i_ __attribute__((ext_vector_type(4))); typedef int v8i_ __attribute__((ext_vector_type(8)));
#define PG8_LDA(dst, b, h) do { _Pragma("unroll") for (int m = 0; m < 4; ++m) { if constexpr (F8) { dst##8[m] = __builtin_shufflevector(*(const LAS v4i_*)(lds + PG8_SA(b, h) + aoff + m * 2048), *(const LAS v4i_*)(lds + PG8_SA(b, h) + aoff + m * 2048 + 1024), 0, 1, 2, 3, 4, 5, 6, 7); } \
        else { _Pragma("unroll") for (int k = 0; k < 2; ++k) dst[m][k] = *(const LAS bf16x8*)(lds + PG8_SA(b, h) + aoff + m * 2048 + k * 1024); } } } while (0)
#define PG8_LDB(dst, b, h) do { _Pragma("unroll") for (int n = 0; n < 2; ++n) { if constexpr (F8) { dst##8[n] = __builtin_shufflevector(*(const LAS v4i_*)(lds + PG8_SB(b, h) + boff + n * 2048), *(const LAS v4i_*)(lds + PG8_SB(b, h) + boff + n * 2048 + 1024), 0, 1, 2, 3, 4, 5, 6, 7); } \
        else { _Pragma("unroll") for (int k = 0; k < 2; ++k) dst[n][k] = *(const LAS bf16x8*)(lds + PG8_SB(b, h) + boff + n * 2048 + k * 1024); } } } while (0)
#define PG8_MMA(ai, bj, At, Bt) do { __builtin_amdgcn_s_setprio(1); _Pragma("unroll") for (int m = 0; m < 4; ++m) _Pragma("unroll") for (int n = 0; n < 2; ++n) { \
          \
        if constexpr (F8) asm("v_mfma_f32_16x16x128_f8f6f4 %0, %1, %2, %0" : "+v"(acc[ai][bj][m][n]) : "v"(Bt##8[n]), "v"(At##8[m]));   \
        else { _Pragma("unroll") for (int k = 0; k < 2; ++k) acc[ai][bj][m][n] = __builtin_amdgcn_mfma_f32_16x16x32_bf16(Bt[n][k], At[m][k], acc[ai][bj][m][n], 0, 0, 0); } } \
        __builtin_amdgcn_s_setprio(0); } while (0)
#define PG8_WAIT_V(n) asm volatile("s_waitcnt vmcnt(" #n ")" ::: "memory")
#define PG8_WAIT_L(n) asm volatile("s_waitcnt lgkmcnt(" #n ")" ::: "memory")
#define PG8_BAR __builtin_amdgcn_s_barrier()
#define PG8_SCHED __builtin_amdgcn_sched_barrier(0)
    Unit cur, nxt; int ui = 0;
    if (!S.next(0, cur)) return;
    f32x4 acc[2][2][4][2];
#pragma unroll
    for (int a = 0; a < 2; ++a)
#pragma unroll
        for (int b = 0; b < 2; ++b)
#pragma unroll
            for (int m = 0; m < 4; ++m)
#pragma unroll
                for (int n = 0; n < 2; ++n) acc[a][b][m][n] = (f32x4){0.f, 0.f, 0.f, 0.f};
    bf16x8 At[4][2], B0[2][2], B1[2][2]; v8i_ At8[4], B08[2], B18[2];
    constexpr bool GATHER = Sched::GATHER;
    unsigned voffA[2]; unsigned cv[2][2], nv[2][2];
#pragma unroll
    for (int i = 0; i < 2; ++i) voffA[i] = (unsigned)(Rr[i] * K + Cc[i]) * 2u;
    const char* cA = Abase; const char* nA = Abase;
    if constexpr (GATHER) S.a_offs(cur, Rr, Cc, cv); else cA = Abase + S.a_tile(cur);
    const char* cB = S.b_tile(cur);
#define PG8_STAGE_A(bufoff, h, kb, NX) do { if constexpr (GATHER) { const unsigned _v[2] = {(NX) ? nv[h][0] : cv[h][0], (NX) ? nv[h][1] : cv[h][1]}; PG8_STAGE(bufoff, Abase + (kb), _v); } \
        else { PG8_STAGE(bufoff, ((NX) ? nA : cA) + (h) * hstep + (kb), voffA); } } while (0)
    PG8_STAGE(PG8_SB(0, 0), cB, voffB); PG8_STAGE(PG8_SB(0, 1), cB + hstep, voffB); PG8_STAGE_A(PG8_SA(0, 0), 0, 0, false); PG8_STAGE_A(PG8_SA(0, 1), 1, 0, false);
    if (wr == 1) PG8_BAR;
    PG8_WAIT_V(2); PG8_BAR;
    PG8_STAGE(PG8_SB(1, 0), cB + kstep, voffB); PG8_STAGE_A(PG8_SA(1, 0), 0, kstep, false); PG8_STAGE(PG8_SB(1, 1), cB + hstep + kstep, voffB);
    PG8_WAIT_V(6); PG8_BAR;
    for (;;) {
        const bool has_next = S.next(ui + 1, nxt);
        const char* nB = cB; nA = cA;
        if (has_next) { if constexpr (GATHER) S.a_offs(nxt, Rr, Cc, nv); else nA = Abase + S.a_tile(nxt); nB = S.b_tile(nxt); }
        else { if constexpr (GATHER) {
#pragma unroll
            for (int h = 0; h < 2; ++h)
#pragma unroll
                for (int i = 0; i < 2; ++i) nv[h][i] = cv[h][i]; } }
#pragma unroll 1
        for (int t = 0; t < nt; t += 2) {
            const bool last = (t == nt - 2);
            const size_t k1 = (size_t)(t + 1) * kstep, k2 = last ? (size_t)0 : (size_t)(t + 2) * kstep, k3 = k2 + kstep;
            const char* b2 = last ? nB : cB + (size_t)(t + 2) * kstep; const char* b3 = b2 + kstep;
            PG8_LDB(B0, 0, 0); PG8_LDB(B1, 0, 1); PG8_SCHED; PG8_LDA(At, 0, 0); PG8_STAGE_A(PG8_SA(1, 1), 1, k1, false);
            PG8_WAIT_V(8); PG8_WAIT_L(0); PG8_BAR; PG8_MMA(0, 0, At, B0); PG8_MMA(0, 1, At, B1); PG8_BAR; PG8_SCHED;
            PG8_LDA(At, 0, 1); PG8_STAGE(PG8_SB(0, 0), b2, voffB); PG8_STAGE(PG8_SB(0, 1), b2 + hstep, voffB); PG8_STAGE_A(PG8_SA(0, 0), 0, k2, last);
            PG8_WAIT_V(8); PG8_WAIT_L(0); PG8_BAR; PG8_MMA(1, 0, At, B0); PG8_MMA(1, 1, At, B1); PG8_BAR; PG8_SCHED;
            PG8_LDB(B0, 1, 0); PG8_LDB(B1, 1, 1); PG8_SCHED; PG8_LDA(At, 1, 0); PG8_STAGE_A(PG8_SA(0, 1), 1, k2, last);
            PG8_WAIT_V(8); PG8_WAIT_L(0); PG8_BAR; PG8_MMA(0, 0, At, B0); PG8_MMA(0, 1, At, B1); PG8_BAR; PG8_SCHED;
            PG8_LDA(At, 1, 1); PG8_STAGE(PG8_SB(1, 0), b3, voffB); PG8_STAGE(PG8_SB(1, 1), b3 + hstep, voffB); PG8_STAGE_A(PG8_SA(1, 0), 0, k3, last);
            PG8_WAIT_V(8); PG8_WAIT_L(0); PG8_BAR; PG8_MMA(1, 0, At, B0); PG8_MMA(1, 1, At, B1); PG8_BAR; PG8_SCHED;
        }
        if constexpr (ALIGN_EPI) { if (wr == 0) PG8_BAR; }
        if constexpr (F8) asm volatile("s_nop 15\n\ts_nop 15" ::: "memory");
        E(acc, cur, wr, wc, fr, fq);
        if (!has_next) break;
#pragma unroll
        for (int a = 0; a < 2; ++a)
#pragma unroll
            for (int b = 0; b < 2; ++b)
#pragma unroll
                for (int m = 0; m < 4; ++m)
#pragma unroll
                    for (int n = 0; n < 2; ++n) acc[a][b][m][n] = (f32x4){0.f, 0.f, 0.f, 0.f};
        cur = nxt; cB = nB; cA = nA; ++ui;
        if constexpr (GATHER) {
#pragma unroll
            for (int h = 0; h < 2; ++h)
#pragma unroll
                for (int i = 0; i < 2; ++i) cv[h][i] = nv[h][i]; }
        if constexpr (ALIGN_EPI) { if (wr == 1) PG8_BAR; }
    }
    PG8_WAIT_V(0);
    if constexpr (!ALIGN_EPI) { if (wr == 0) PG8_BAR; }
    PG8_BAR;
#undef PG8_SA
#undef PG8_SB
#undef PG8_STAGE
#undef PG8_STAGE_A
#undef PG8_LDA
#undef PG8_LDB
#undef PG8_MMA
#undef PG8_WAIT_V
#undef PG8_WAIT_L
#undef PG8_BAR
#undef PG8_SCHED
}
}

#define XB_TMO      128
#define XB_XCNT(j)  (256  + 64 * (j))
#define XB_XSUB(j)  (1280 + 64 * (j))
#define XB_XGEN(j)  (2304 + 64 * (j))
#define XB_TOP      3328
#define XB_TOPGEN   3392
#define XCD_BAR_WORDS 3456
#define XB_SPIN_CAP (1u << 18)
__device__ __forceinline__ unsigned xb_ld(unsigned* p)              { return __hip_atomic_load(p, __ATOMIC_RELAXED, __HIP_MEMORY_SCOPE_AGENT); }
__device__ __forceinline__ unsigned xb_add(unsigned* p, unsigned v) { return __hip_atomic_fetch_add(p, v, __ATOMIC_RELAXED, __HIP_MEMORY_SCOPE_AGENT); }
__device__ __forceinline__ unsigned xb_xcc_id() { return (unsigned)__builtin_amdgcn_s_getreg((3 << 11) | 20) & 0xFu; }
#define XB_SPIN(cond, bar) do { unsigned _sp = 0; while (cond) { __builtin_amdgcn_s_sleep(1); \
    if ((++_sp & 255u) == 0u) { if (xb_ld(&(bar)[XB_TMO])) break; if (_sp > XB_SPIN_CAP) { atomicAdd(&(bar)[XB_TMO], 1u); break; } } } } while (0)
struct XcdBarrier { unsigned* bar; unsigned x; volatile LAS unsigned* st; };
__device__ __forceinline__ XcdBarrier xcd_barrier_post(unsigned* bar, volatile LAS unsigned* st) {
    XcdBarrier b; b.bar = bar; b.x = xb_xcc_id(); b.st = st;
    if (threadIdx.x == 0) (void)xb_add(&bar[XB_XCNT(b.x)], 1u);
    return b;
}
__device__ __forceinline__ void xcd_barrier_complete(unsigned* bar, unsigned x, unsigned& nloc, unsigned& nx) {
    const unsigned G = gridDim.x * gridDim.y * gridDim.z;
    unsigned sum, cnt, mine, sp = 0u;
    for (;;) {
        sum = 0u; cnt = 0u; mine = 0u;
#pragma unroll
        for (unsigned j = 0; j < 16; ++j) { const unsigned c = xb_ld(&bar[XB_XCNT(j)]); sum += c; cnt += (c > 0u) ? 1u : 0u; mine = (j == x) ? c : mine; }
        if (sum == G) break;
        __builtin_amdgcn_s_sleep(1);
        if ((++sp & 255u) == 0u) { if (xb_ld(&bar[XB_TMO])) break; if (sp > XB_SPIN_CAP) { atomicAdd(&bar[XB_TMO], 1u); break; } }
    }
    nloc = mine > 0u ? mine : 1u; nx = cnt > 0u ? cnt : 1u;
}
__device__ __forceinline__ void xcd_barrier(const XcdBarrier& b) {
    asm volatile("s_waitcnt vmcnt(0)" ::: "memory");
    __syncthreads();
    if (threadIdx.x == 0) {
        unsigned* bar = b.bar;
        __builtin_amdgcn_s_waitcnt(0);
        unsigned nloc = b.st[0], nx = b.st[1];
        if (nloc == 0u) { xcd_barrier_complete(bar, b.x, nloc, nx); b.st[0] = nloc; b.st[1] = nx; }
        const unsigned old = xb_add(&bar[XB_XSUB(b.x)], 1u);
        const unsigned gen = old / nloc;
        if (old + 1u == (gen + 1u) * nloc) {
            __builtin_amdgcn_fence(__ATOMIC_RELEASE, "agent");
            asm volatile("s_waitcnt vmcnt(0)" ::: "memory");
            const unsigned og = xb_add(&bar[XB_TOP], 1u);
            const unsigned tg = og / nx;
            if (og + 1u == (tg + 1u) * nx) xb_add(&bar[XB_TOPGEN], 1u);
            else XB_SPIN(xb_ld(&bar[XB_TOPGEN]) == tg, bar);
            __builtin_amdgcn_fence(__ATOMIC_ACQUIRE, "agent");
            xb_add(&bar[XB_XGEN(b.x)], 1u);
            asm volatile("s_waitcnt vmcnt(0)" ::: "memory");
        } else {
            XB_SPIN(xb_ld(&bar[XB_XGEN(b.x)]) == gen, bar);
            __builtin_amdgcn_fence(__ATOMIC_ACQUIRE, "agent");
            asm volatile("s_waitcnt vmcnt(0)" ::: "memory");
        }
    }
    __syncthreads();
}

struct Params {
    const float *x, *c, *ctx, *c_ctx, *ada_w, *ada_b, *w_in, *w_out, *na_rpb, *diff_lambda, *diff_subln, *conv_w,
                *ffn_w1, *ffn_w3, *ffn_w2, *router_w, *moe_w1, *moe_w3, *moe_w2, *final_gain;
    float* out; unsigned char* ws;
    int ph_lo, ph_hi, li, pad;
};
struct Ctx {
    LAS unsigned char* lds; char* ldsg;
    volatile LAS unsigned* MISC;
    gu32* ctl;
    int tid, lane, wave, vcu, G;
    unsigned char* ws;
};
__device__ __forceinline__ Ctx fresh(const Ctx& X0) { Ctx X = X0; X.tid = fresh_tid(); X.lane = X.tid & 63; X.wave = __builtin_amdgcn_readfirstlane(X.tid >> 6); return X; }
__device__ __forceinline__ const float* modp(const Ctx& X, int layer, int v, int idx) { return (const float*)(X.ws + WS_MODS) + ((size_t)(layer * 3 + v) * 6 + idx) * D; }

struct SchedPlain {
    static constexpr bool GATHER = false;
    pg8::TileOrder T; const char* Bt; int K;
    __device__ __forceinline__ bool next(int i, pg8::Unit& u) const { u.e = 0; const bool ok = T.tile(i, u.pm, u.pn); u.pl = u.pm; return ok; }
    __device__ __forceinline__ size_t a_tile(const pg8::Unit& u) const { return (size_t)u.pm * 256 * K * 2; }
    __device__ __forceinline__ void a_offs(const pg8::Unit&, const int (&)[2], const int (&)[2], unsigned (&)[2][2]) const {}
    __device__ __forceinline__ const char* b_tile(const pg8::Unit& u) const { return Bt + (size_t)u.pn * 256 * K * 2; }
};
template <bool GATHER_> struct SchedMoe {
    static constexpr bool GATHER = GATHER_;
    pg8::TileOrder T; const char* Bt; int K; size_t estride; volatile LAS unsigned* M; const int* tokl;
    __device__ __forceinline__ bool next(int i, pg8::Unit& u) const {
        const bool ok = T.tile(i, u.pm, u.pn); if (!ok) return false;
        int e = 0;
#pragma unroll
        for (int k = 1; k < NEXP; ++k) e += ((int)M[16 + k] <= u.pm) ? 1 : 0;
        u.e = __builtin_amdgcn_readfirstlane(e); u.pl = u.pm - (int)M[16 + u.e]; return true;
    }
    __device__ __forceinline__ size_t a_tile(const pg8::Unit& u) const { return (size_t)u.pm * 256 * K * 2; }
    __device__ __forceinline__ void a_offs(const pg8::Unit& u, const int (&R)[2], const int (&C)[2], unsigned (&v)[2][2]) const {
        const int cnt = (int)M[32 + u.e];
#pragma unroll
        for (int h = 0; h < 2; ++h)
#pragma unroll
            for (int i = 0; i < 2; ++i) { const int idx = u.pl * 256 + h * 128 + R[i]; const int tok = idx < cnt ? tokl[u.e * 16384 + idx] : 0; v[h][i] = (unsigned)(tok * K + C[i]) * 2u; }
    }
    __device__ __forceinline__ const char* b_tile(const pg8::Unit& u) const { return Bt + (size_t)u.e * estride + (size_t)u.pn * 256 * K * 2; }
};

struct EpiInProj {
    static constexpr bool PERM = true;
    bf16_t* QKV; const f32x2* tabR; const f32x2* tabC;
    __device__ __forceinline__ void operator()(const f32x4 (&acc)[2][2][4][2], const pg8::Unit& u, int wr, int wc, int fr, int fq) const {
        const int pm = u.pm, pn = u.pn; const bool isctx = pm >= 64;
        const int opanel = isctx ? (pm - 64) * 33 : (pm + 1 + (pm >= 32 ? 1 : 0));
        const int orow0 = opanel * 256 + wr * 64 + fr, arow0 = pm * 256 + wr * 64 + fr;
        const int col0 = pn * 256 + wc * 32 + 8 * fq;
        const bool rope = !isctx && (pn == 1 || pn == 2 || pn == 4 || pn == 5);
        const float sc = (pn <= 2) ? C2 : 1.f;
#pragma unroll
        for (int ai = 0; ai < 2; ++ai)
#pragma unroll
            for (int m = 0; m < 4; ++m) {
                const int t = (arow0 + ai * 128 + m * 16) & (SEQ - 1);
                f32x4 cs0 = (f32x4){1.f, 0.f, 1.f, 0.f}, cs1 = cs0;
                if (rope) { const f32x4* tb = (const f32x4*)(((wc & 1) ? tabC + (t & 63) * 16 : tabR + (t >> 6) * 16) + 4 * fq); cs0 = tb[0]; cs1 = tb[1]; }
                bf16_t* rowp = QKV + (size_t)(orow0 + ai * 128 + m * 16) * INC + col0;
#pragma unroll
                for (int bj = 0; bj < 2; ++bj) {
                    f32x4 v0 = acc[ai][bj][m][0], v1 = acc[ai][bj][m][1];
                    if (rope) {
                        const f32x4 c = (f32x4){cs0[0], cs0[2], cs1[0], cs1[2]}, s = (f32x4){cs0[1], cs0[3], cs1[1], cs1[3]};
                        const f32x4 o1 = v0 * c - v1 * s, o2 = v1 * c + v0 * s; v0 = o1; v1 = o2;
                    }
                    v0 = v0 * sc; v1 = v1 * sc;
                    u32x4 w; w.x = cvt_pk_bf16(v0[0], v0[1]); w.y = cvt_pk_bf16(v0[2], v0[3]); w.z = cvt_pk_bf16(v1[0], v1[1]); w.w = cvt_pk_bf16(v1[2], v1[3]);
                    *(u32x4*)(rowp + bj * 128) = w;
                }
            }
    }
};
struct EpiResGate {
    static constexpr bool PERM = false;
    const float* base_lat; const float* base_ctx; float* out_lat; float* out_ctx; const float* gate0;
    __device__ __forceinline__ void operator()(const f32x4 (&acc)[2][2][4][2], const pg8::Unit& u, int wr, int wc, int fr, int fq) const {
        const int pm = u.pm; const int v = pm < 32 ? 0 : (pm < 64 ? 1 : 2);
        const float* base = pm < 64 ? base_lat : base_ctx; float* out = pm < 64 ? out_lat : out_ctx;
        const int row0 = (pm < 64 ? pm : pm - 64) * 256 + wr * 64 + fr;
        const int col0 = u.pn * 256 + wc * 32 + 4 * fq;
        const float* g = gate0 + (size_t)v * 6 * D + col0;
        f32x4 gv[2][2];
#pragma unroll
        for (int bj = 0; bj < 2; ++bj)
#pragma unroll
            for (int n = 0; n < 2; ++n) gv[bj][n] = *(const f32x4*)(g + bj * 128 + n * 16);
#pragma unroll
        for (int ai = 0; ai < 2; ++ai)
#pragma unroll
            for (int m = 0; m < 4; ++m) { const size_t off = (size_t)(row0 + ai * 128 + m * 16) * D + col0;
#pragma unroll
                for (int bj = 0; bj < 2; ++bj)
#pragma unroll
                    for (int n = 0; n < 2; ++n) { const f32x4 bs = *(const f32x4*)(base + off + bj * 128 + n * 16); *(f32x4*)(out + off + bj * 128 + n * 16) = bs + gv[bj][n] * acc[ai][bj][m][n]; }
                if (m & 1) asm volatile("" ::: "memory"); }
    }
};
__device__ __forceinline__ float silu_f(float x) { return x * __builtin_amdgcn_rcpf(1.f + __builtin_amdgcn_exp2f(-x * LOG2E)); }
struct EpiSwiGLU {
    static constexpr bool PERM = true;
    bf16_t* H; int ldc;
    __device__ __forceinline__ void operator()(const f32x4 (&acc)[2][2][4][2], const pg8::Unit& u, int wr, int wc, int fr, int fq) const {
        const int row0 = u.pm * 256 + wr * 64 + fr, col0 = u.pn * 128 + wc * 16 + 4 * fq;
#pragma unroll
        for (int ai = 0; ai < 2; ++ai)
#pragma unroll
            for (int m = 0; m < 4; ++m) { bf16_t* rowp = H + (size_t)(row0 + ai * 128 + m * 16) * ldc + col0;
#pragma unroll
                for (int bj = 0; bj < 2; ++bj) { const f32x4 a = acc[ai][bj][m][0], b = acc[ai][bj][m][1];
                    u32x2 w; w.x = cvt_pk_bf16(silu_f(a[0]) * b[0], silu_f(a[1]) * b[1]); w.y = cvt_pk_bf16(silu_f(a[2]) * b[2], silu_f(a[3]) * b[3]);
                    *(u32x2*)(rowp + bj * 64) = w; } }
    }
};
struct EpiStoreBf16 {
    static constexpr bool PERM = true;
    bf16_t* Y; float scale;
    __device__ __forceinline__ void operator()(const f32x4 (&acc)[2][2][4][2], const pg8::Unit& u, int wr, int wc, int fr, int fq) const {
        const int row0 = u.pm * 256 + wr * 64 + fr, col0 = u.pn * 256 + wc * 32 + 8 * fq;
#pragma unroll
        for (int ai = 0; ai < 2; ++ai)
#pragma unroll
            for (int m = 0; m < 4; ++m) { bf16_t* rowp = Y + (size_t)(row0 + ai * 128 + m * 16) * D + col0;
#pragma unroll
                for (int bj = 0; bj < 2; ++bj) { const f32x4 v0 = acc[ai][bj][m][0] * scale, v1 = acc[ai][bj][m][1] * scale;
                    u32x4 w; w.x = cvt_pk_bf16(v0[0], v0[1]); w.y = cvt_pk_bf16(v0[2], v0[3]); w.z = cvt_pk_bf16(v1[0], v1[1]); w.w = cvt_pk_bf16(v1[2], v1[3]);
                    *(u32x4*)(rowp + bj * 128) = w; } }
    }
};
struct EpiSwiGLU8 {
    static constexpr bool PERM = true;
    unsigned char* H; int ldc;
    __device__ __forceinline__ void operator()(const f32x4 (&acc)[2][2][4][2], const pg8::Unit& u, int wr, int wc, int fr, int fq) const {
        const int row0 = u.pm * 256 + wr * 64 + fr, col0 = u.pn * 128 + wc * 16 + 4 * fq; const float is = 1.f / MOE_W13_SCALE;
#pragma unroll
        for (int ai = 0; ai < 2; ++ai)
#pragma unroll
            for (int m = 0; m < 4; ++m) { unsigned char* rowp = H + (size_t)(row0 + ai * 128 + m * 16) * ldc + col0;
#pragma unroll
                for (int bj = 0; bj < 2; ++bj) { const f32x4 a = acc[ai][bj][m][0] * is, b = acc[ai][bj][m][1] * is;
                    *(unsigned*)(rowp + bj * 64) = pk_fp8x4(silu_f(a[0]) * b[0], silu_f(a[1]) * b[1], silu_f(a[2]) * b[2], silu_f(a[3]) * b[3]); } }
    }
};
struct SchedMoeTail {
    static constexpr bool GATHER = false;
    int first, count; const char* Bt; int K; size_t estride; volatile LAS unsigned* M;
    __device__ __forceinline__ bool next(int i, pg8::Unit& u) const {
        if (i > 0 || first >= count) return false;
        const int sl = first % 7, rest = first / 7; u.pn = rest & 3; u.pm = 128 + (rest >> 2); u.pl = sl;
        int e = 0;
#pragma unroll
        for (int k = 1; k < NEXP; ++k) e += ((int)M[16 + k] <= u.pm) ? 1 : 0;
        u.e = __builtin_amdgcn_readfirstlane(e); return true;
    }
    __device__ __forceinline__ size_t a_tile(const pg8::Unit& u) const { return (size_t)u.pm * 256 * K * 2 + (size_t)u.pl * 512; }
    __device__ __forceinline__ void a_offs(const pg8::Unit&, const int (&)[2], const int (&)[2], unsigned (&)[2][2]) const {}
    __device__ __forceinline__ const char* b_tile(const pg8::Unit& u) const { return Bt + (size_t)u.e * estride + (size_t)u.pn * 256 * K * 2 + (size_t)u.pl * 512; }
};
struct EpiTailPart {
    static constexpr bool PERM = false;
    bf16_t* Yt; float scale;
    __device__ __forceinline__ void operator()(const f32x4 (&acc)[2][2][4][2], const pg8::Unit& u, int wr, int wc, int fr, int fq) const {
        const int row0 = u.pl * 2048 + (u.pm - 128) * 256 + wr * 64 + fr, col0 = u.pn * 256 + wc * 32 + 4 * fq;
#pragma unroll
        for (int ai = 0; ai < 2; ++ai)
#pragma unroll
            for (int m = 0; m < 4; ++m) { bf16_t* rowp = Yt + (size_t)(row0 + ai * 128 + m * 16) * D + col0;
#pragma unroll
                for (int bj = 0; bj < 2; ++bj)
#pragma unroll
                    for (int n = 0; n < 2; ++n) { const f32x4 v = acc[ai][bj][m][n] * scale; u32x2 w; w.x = cvt_pk_bf16(v[0], v[1]); w.y = cvt_pk_bf16(v[2], v[3]); *(u32x2*)(rowp + bj * 128 + n * 16) = w; } }
    }
};

struct ThinInProj {
    bf16_t* QKV; int col_off;
    __device__ __forceinline__ void operator()(int row, int col, const float (&v)[8]) const {
        const int c = col + col_off; const float sc = c < C_KA ? C2 : 1.f;
        u32x4 w; w.x = cvt_pk_bf16(v[0] * sc, v[1] * sc); w.y = cvt_pk_bf16(v[2] * sc, v[3] * sc); w.z = cvt_pk_bf16(v[4] * sc, v[5] * sc); w.w = cvt_pk_bf16(v[6] * sc, v[7] * sc);
        *(u32x4*)(QKV + (size_t)((row >> 8) * KVR + (row & 255)) * INC + c) = w;
    }
};
struct ThinResGate {
    const float* base; float* out; const float* gate;
    __device__ __forceinline__ void operator()(int row, int col, const float (&v)[8]) const {
        const size_t off = (size_t)row * D + col;
        const f32x4 g0 = *(const f32x4*)(gate + col), g1 = *(const f32x4*)(gate + col + 4), b0 = *(const f32x4*)(base + off), b1 = *(const f32x4*)(base + off + 4);
        *(f32x4*)(out + off) = b0 + g0 * (f32x4){v[0], v[1], v[2], v[3]}; *(f32x4*)(out + off + 4) = b1 + g1 * (f32x4){v[4], v[5], v[6], v[7]};
    }
};
struct ThinSwiGLU {
    bf16_t* H; int ldc;
    __device__ __forceinline__ void operator()(int row, int col, const float (&v)[8]) const {
        u32x2 w; w.x = cvt_pk_bf16(silu_f(v[0]) * v[4], silu_f(v[1]) * v[5]); w.y = cvt_pk_bf16(silu_f(v[2]) * v[6], silu_f(v[3]) * v[7]);
        *(u32x2*)(H + (size_t)row * ldc + (col >> 1)) = w;
    }
};
template <class Epi8>
__device__ __forceinline__ void thin_gemm(const Ctx& X0, const bf16_t* A, const bf16_t* Bt, int N, int K, const Epi8& E, int first, int stride) {
    const Ctx X = fresh(X0);
    constexpr int PST = 68, TB = 16384;
    const int lane = X.lane, wid = X.wave, r32 = lane & 31, hi = lane >> 5, mi = wid & 1, ni = (wid >> 1) & 1, kh = wid >> 2;
    LAS char* L = (LAS char*)X.lds;
    LAS float* Pl = (LAS float*)(L + 4 * TB);
    const int srow = X.tid >> 3, sch = X.tid & 7;
    const int sw0 = srow * 256 + ((sch ^ (srow & 7)) * 16), sw1 = sw0 + 128;
    const int ra = 32 * mi + r32, rb = 32 * ni + r32, fa = ra * 256, fb = rb * 256, xa = ra & 7, xb = rb & 7;
    const int nTn = N / 64, nk = K / 128;
    for (int tile = first; tile < 8 * nTn; tile += stride) {
        const int tm = tile & 7, tn = tile >> 3;
        const bf16_t* ag = A + (size_t)(tm * 64 + srow) * K + sch * 8; const bf16_t* bg = Bt + (size_t)(tn * 64 + srow) * K + sch * 8;
        bf16x8 ea0 = *(const bf16x8*)ag, ea1 = *(const bf16x8*)(ag + 64), eb0 = *(const bf16x8*)bg, eb1 = *(const bf16x8*)(bg + 64);
        bf16x8 oa0 = *(const bf16x8*)(ag + 128), oa1 = *(const bf16x8*)(ag + 192), ob0 = *(const bf16x8*)(bg + 128), ob1 = *(const bf16x8*)(bg + 192);
        f32x16 c = {};
#define THIN_COMPUTE(ta, tb) do { _Pragma("unroll") for (int jj = 0; jj < 4; ++jj) { const int ci = 2 * (4 * kh + jj) + hi; \
            const bf16x8 af = *(const LAS bf16x8*)((ta) + fa + ((ci ^ xa) * 16)), bf = *(const LAS bf16x8*)((tb) + fb + ((ci ^ xb) * 16)); \
            c = __builtin_amdgcn_mfma_f32_32x32x16_bf16(af, bf, c, 0, 0, 0); } } while (0)
        for (int s = 0; s < nk; s += 2) {
            LAS char* ta = L; LAS char* tb = L + 2 * TB;
            *(LAS bf16x8*)(ta + sw0) = ea0; *(LAS bf16x8*)(ta + sw1) = ea1; *(LAS bf16x8*)(tb + sw0) = eb0; *(LAS bf16x8*)(tb + sw1) = eb1;
            __syncthreads();
            if (s + 2 < nk) { const int ko = (s + 2) * 128; ea0 = *(const bf16x8*)(ag + ko); ea1 = *(const bf16x8*)(ag + ko + 64); eb0 = *(const bf16x8*)(bg + ko); eb1 = *(const bf16x8*)(bg + ko + 64); }
            THIN_COMPUTE(ta, tb);
            ta += TB; tb += TB;
            *(LAS bf16x8*)(ta + sw0) = oa0; *(LAS bf16x8*)(ta + sw1) = oa1; *(LAS bf16x8*)(tb + sw0) = ob0; *(LAS bf16x8*)(tb + sw1) = ob1;
            __syncthreads();
            if (s + 3 < nk) { const int ko = (s + 3) * 128; oa0 = *(const bf16x8*)(ag + ko); oa1 = *(const bf16x8*)(ag + ko + 64); ob0 = *(const bf16x8*)(bg + ko); ob1 = *(const bf16x8*)(bg + ko + 64); }
            THIN_COMPUTE(ta, tb);
        }
#undef THIN_COMPUTE
        LAS float* pw = Pl + kh * 64 * PST + ni * 32 + r32;
#pragma unroll
        for (int r = 0; r < 16; ++r) pw[(32 * mi + (r & 3) + 8 * (r >> 2) + 4 * hi) * PST] = c[r];
        __syncthreads();
        { const int row = X.tid >> 3, c8 = (X.tid & 7) * 8; float v[8];
            const LAS float* pr = Pl + row * PST + c8;
            const f32x4 s0 = *(const LAS f32x4*)pr + *(const LAS f32x4*)(pr + 64 * PST), s1 = *(const LAS f32x4*)(pr + 4) + *(const LAS f32x4*)(pr + 64 * PST + 4);
            v[0] = s0[0]; v[1] = s0[1]; v[2] = s0[2]; v[3] = s0[3]; v[4] = s1[0]; v[5] = s1[1]; v[6] = s1[2]; v[7] = s1[3];
            E(tm * 64 + row, tn * 64 + c8, v); }
        __syncthreads();
    }
}

__device__ __forceinline__ unsigned f2bf(float f) { unsigned u = __builtin_bit_cast(unsigned, f); return (u + 0x7fffu + ((u >> 16) & 1u)) >> 16; }
__device__ __forceinline__ unsigned pk2(float lo, float hi) { return f2bf(lo) | (f2bf(hi) << 16); }
template <int MODE> __device__ __forceinline__ int dest_row(int n) {
    if (MODE == 1) { if ((n >= C_QB && n < C_KA) || (n >= C_KB && n < C_VA)) { const int i = n & 63, base = n & ~63; return base + ((i < 32) ? 8 * (i >> 2) + (i & 3) : 8 * ((i - 32) >> 2) + 4 + (i & 3)); } return n; }
    if (MODE == 2) return 8 * (n >> 2) + (n & 3);
    if (MODE == 3) return 8 * (n >> 2) + 4 + (n & 3);
    return n;
}
template <int MODE> __device__ __forceinline__ void p0_transpose_item(const float* W, int K, int N, bf16_t* WT, LAS float* scr, int item, int lane) {
    const int nblk = N / 32, kb = item / nblk, nb = item % nblk, k0 = 64 * kb, n0 = 32 * nb;
#pragma unroll 8
    for (int i = 0; i < 32; ++i) { const int kk = 2 * i + (lane >> 5); scr[kk * 33 + (lane & 31)] = W[(size_t)(k0 + kk) * N + n0 + (lane & 31)]; }
    LDS_WAIT(); asm volatile("" ::: "memory");
    const int c = lane & 7;
#pragma unroll
    for (int j = 0; j < 4; ++j) { const int n = (lane >> 3) + 8 * j; const LAS float* s = scr + (8 * c) * 33 + n;
        u32x4 o; o.x = pk2(s[0 * 33], s[1 * 33]); o.y = pk2(s[2 * 33], s[3 * 33]); o.z = pk2(s[4 * 33], s[5 * 33]); o.w = pk2(s[6 * 33], s[7 * 33]);
        st16_wt(WT + (size_t)dest_row<MODE>(n0 + n) * K + k0 + 8 * c, o); }
    LDS_WAIT(); asm volatile("" ::: "memory");
}
template <int MODE> __device__ __forceinline__ void p0_transpose_item_f8(const float* W, int K, int N, unsigned char* WT8, float scale, LAS float* scr, int item, int lane) {
    const int nblk = N / 32, kb = item / nblk, nb = item % nblk, k0 = 64 * kb, n0 = 32 * nb;
#pragma unroll 8
    for (int i = 0; i < 32; ++i) { const int kk = 2 * i + (lane >> 5); scr[kk * 33 + (lane & 31)] = W[(size_t)(k0 + kk) * N + n0 + (lane & 31)] * scale; }
    LDS_WAIT(); asm volatile("" ::: "memory");
    const int c = lane & 7;
#pragma unroll
    for (int j = 0; j < 4; ++j) { const int n = (lane >> 3) + 8 * j; const LAS float* q = scr + (8 * c) * 33 + n;
        u32x2 o; o.x = pk_fp8x4(q[0 * 33], q[1 * 33], q[2 * 33], q[3 * 33]); o.y = pk_fp8x4(q[4 * 33], q[5 * 33], q[6 * 33], q[7 * 33]);
        st8_wt(WT8 + (size_t)dest_row<MODE>(n0 + n) * K + k0 + 8 * c, o); }
    LDS_WAIT(); asm volatile("" ::: "memory");
}
__device__ __forceinline__ void sincos_d(double x, double& s, double& c) {
    const double k = __builtin_rint(x * 0.63661977236758134308);
    double r = __builtin_fma(-k, 1.57079632679489655800e+00, x); r = __builtin_fma(-k, 6.12323399573676603587e-17, r);
    const double r2 = r * r;
    double sp = -7.6471637318198164759e-13; sp = sp * r2 + 1.6059043836821614599e-10; sp = sp * r2 - 2.5052108385441718775e-08; sp = sp * r2 + 2.7557319223985890653e-06;
    sp = sp * r2 - 1.9841269841269841270e-04; sp = sp * r2 + 8.3333333333333333333e-03; sp = sp * r2 - 1.6666666666666666667e-01; const double sr = r + r * r2 * sp;
    double cp = 4.7794773323873852974e-14; cp = cp * r2 - 1.1470745597729724714e-11; cp = cp * r2 + 2.0876756987868098979e-09; cp = cp * r2 - 2.7557319223985890653e-07;
    cp = cp * r2 + 2.4801587301587301587e-05; cp = cp * r2 - 1.3888888888888888889e-03; cp = cp * r2 + 4.1666666666666666667e-02; cp = cp * r2 - 0.5; const double cr = 1.0 + r2 * cp;
    const int q = ((int)k) & 3;
    s = (q == 0) ? sr : (q == 1) ? cr : (q == 2) ? -sr : -cr;
    c = (q == 0) ? cr : (q == 1) ? -sr : (q == 2) ? -cr : sr;
}
__device__ __forceinline__ float inv_freq(int f) {
    float v = (f & 3) == 0 ? 1.0f : (f & 3) == 1 ? 0.5623413251903491f : (f & 3) == 2 ? 0.31622776601683794f : 0.1778279410038923f;
    const int d = f >> 2; v *= (d == 0) ? 1.0f : (d == 1) ? 0.1f : (d == 2) ? 0.01f : 0.001f; return v;
}
struct P0D { const float* W; unsigned char* WT; int K, N, item, mode, f8; float scale; };
constexpr int I_IN = 16 * 96, I_OUT = 16 * 32, I_F13 = 16 * 88, I_F2 = 44 * 32, I_M13 = 16 * 112, I_M2 = 56 * 32;
constexpr int P0_NITEMS = 2 * I_IN + 2 * I_OUT + 2 * I_F13 + I_F2 + 16 * I_M13 + 8 * I_M2;
__device__ __forceinline__ P0D p0_decode(const Ctx& X, const Params& P, int it) {
    P0D d; int r = it; d.scale = 1.f; d.f8 = 0;
    if (r < 2 * I_IN) { const int l = r / I_IN; d.W = P.w_in + (size_t)l * D * INC; d.K = D; d.N = INC; d.WT = X.ws + WS_WIN + (size_t)l * INC * D * 2; d.mode = 1; d.item = r % I_IN; return d; } r -= 2 * I_IN;
    if (r < 2 * I_OUT) { const int l = r / I_OUT; d.W = P.w_out + (size_t)l * D * D; d.K = D; d.N = D; d.WT = X.ws + WS_WOUT + (size_t)l * D * D * 2; d.mode = 0; d.item = r % I_OUT; return d; } r -= 2 * I_OUT;
    if (r < I_F13) { d.W = P.ffn_w1; d.K = D; d.N = DFF; d.WT = X.ws + WS_W13; d.mode = 2; d.item = r; return d; } r -= I_F13;
    if (r < I_F13) { d.W = P.ffn_w3; d.K = D; d.N = DFF; d.WT = X.ws + WS_W13; d.mode = 3; d.item = r; return d; } r -= I_F13;
    if (r < I_F2) { d.W = P.ffn_w2; d.K = DFF; d.N = D; d.WT = X.ws + WS_W2; d.mode = 0; d.item = r; return d; } r -= I_F2;
    d.f8 = 1;
    if (r < 8 * I_M13) { const int e = r / I_M13; d.W = P.moe_w1 + (size_t)e * D * DEXP; d.K = D; d.N = DEXP; d.WT = X.ws + WS_MW13 + (size_t)e * 2 * DEXP * D; d.mode = 2; d.item = r % I_M13; d.scale = MOE_W13_SCALE; return d; } r -= 8 * I_M13;
    if (r < 8 * I_M13) { const int e = r / I_M13; d.W = P.moe_w3 + (size_t)e * D * DEXP; d.K = D; d.N = DEXP; d.WT = X.ws + WS_MW13 + (size_t)e * 2 * DEXP * D; d.mode = 3; d.item = r % I_M13; d.scale = MOE_W13_SCALE; return d; } r -= 8 * I_M13;
    { const int e = r / I_M2; d.W = P.moe_w2 + (size_t)e * DEXP * D; d.K = DEXP; d.N = D; d.WT = X.ws + WS_MW2 + (size_t)e * D * DEXP; d.mode = 0; d.item = r % I_M2; d.scale = MOE_W2_SCALE; return d; }
}
__device__ __forceinline__ void p0_prologue(const Ctx& X0, const Params& P) {
    const Ctx X = fresh(X0);
    LAS float* scr = (LAS float*)(X.lds + X.wave * 16384);
    const int gw = X.vcu * NWAVES + X.wave, NGW = X.G * NWAVES;
    float vn[32];
    constexpr int MOD_ITEMS = 2 * (6 * D / 64);
    if (X.vcu < MOD_ITEMS) {
        LAS float* sv = (LAS float*)(X.lds);
        LAS float* red = (LAS float*)(X.lds + 16384);
        for (int i = X.tid; i < 3 * D; i += NWAVES * 64) { const int v = i / D, k = i % D; const float cv = v < 2 ? P.c[v * D + k] : P.c_ctx[k]; sv[i] = cv / (1.f + __expf(-cv)); }
        __syncthreads();
        const int l = X.vcu / 96, n0 = (X.vcu % 96) * 64;
        const int kg = X.tid >> 4, cl = X.tid & 15;
        const float* W = P.ada_w + (size_t)l * D * 6 * D + n0 + cl * 4;
        f32x4 a0 = {0.f, 0.f, 0.f, 0.f}, a1 = a0, a2 = a0;
#pragma unroll 8
        for (int kk = 0; kk < 32; ++kk) { const int k = kg * 32 + kk; const f32x4 w = *(const f32x4*)(W + (size_t)k * 6 * D); a0 += w * sv[k]; a1 += w * sv[D + k]; a2 += w * sv[2 * D + k]; }
#pragma unroll
        for (int j = 0; j < 4; ++j) { red[(kg * 3 + 0) * 64 + cl * 4 + j] = a0[j]; red[(kg * 3 + 1) * 64 + cl * 4 + j] = a1[j]; red[(kg * 3 + 2) * 64 + cl * 4 + j] = a2[j]; }
        __syncthreads();
        if (X.tid < 192) { const int v = X.tid / 64, cc = X.tid % 64; float s = 0.f;
            for (int g = 0; g < 32; ++g) s += red[(g * 3 + v) * 64 + cc];
            ((float*)(X.ws + WS_MODS))[(size_t)(l * 3 + v) * 6 * D + n0 + cc] = s + P.ada_b[l * 6 * D + n0 + cc]; }
        __syncthreads();
    } else if (X.vcu == MOD_ITEMS) {
        f32x2* tabR = (f32x2*)(X.ws + WS_TABR); f32x2* tabC = (f32x2*)(X.ws + WS_TABC);
        for (int i = X.tid; i < 192 * 16; i += NWAVES * 64) { const int pos = i >> 4, f = i & 15; const int p = pos < 128 ? pos : pos - 128;
            const float ang = (float)p * inv_freq(f); double s, c; sincos_d((double)ang, s, c);
            const f32x2 cs = {(float)c, (float)s}; if (pos < 128) tabR[pos * 16 + f] = cs; else tabC[(pos - 128) * 16 + f] = cs; }
        if (X.wave < 2) { const float* dl = P.diff_lambda + X.wave * 256;
            const float s1 = wave_sum(dl[X.lane] * dl[64 + X.lane]), s2 = wave_sum(dl[128 + X.lane] * dl[192 + X.lane]);
            const float linit = X.wave == 0 ? 0.2f : (0.8f - 0.6f * 0.74081822068171786607f);
            if (X.lane == 0) ((float*)(X.ws + WS_LAM))[X.wave] = __expf(s1) - __expf(s2) + linit; }
    }
    for (int it = gw; it < P0_NITEMS; ) {
        const P0D d = p0_decode(X, P, it);
        const int nblk = d.N / 32, kb = d.item / nblk, nb = d.item % nblk, k0 = 64 * kb, n0 = 32 * nb;
        float v[32];
        if (it == gw) { const float* src = d.W + (size_t)(k0 + (X.lane >> 5)) * d.N + n0 + (X.lane & 31);
#pragma unroll
            for (int i = 0; i < 32; ++i) v[i] = src[(size_t)(2 * i) * d.N]; }
        else {
#pragma unroll
            for (int i = 0; i < 32; ++i) v[i] = vn[i]; }
#pragma unroll
        for (int i = 0; i < 32; ++i) scr[(2 * i + (X.lane >> 5)) * 33 + (X.lane & 31)] = v[i] * d.scale;
        LDS_WAIT(); asm volatile("" ::: "memory");
        const int itn = it + NGW;
        if (itn < P0_NITEMS) { const P0D dn = p0_decode(X, P, itn);
            const int nblkn = dn.N / 32, kbn = dn.item / nblkn, nbn = dn.item % nblkn;
            const float* src = dn.W + (size_t)(64 * kbn + (X.lane >> 5)) * dn.N + 32 * nbn + (X.lane & 31);
#pragma unroll
            for (int i = 0; i < 32; ++i) vn[i] = src[(size_t)(2 * i) * dn.N]; }
        const int c = X.lane & 7;
#pragma unroll
        for (int j = 0; j < 4; ++j) { const int n = (X.lane >> 3) + 8 * j; const LAS float* q = scr + (8 * c) * 33 + n;
            const int dr = d.mode == 1 ? dest_row<1>(n0 + n) : d.mode == 2 ? dest_row<2>(n0 + n) : d.mode == 3 ? dest_row<3>(n0 + n) : n0 + n;
            const size_t eo = (size_t)dr * d.K + k0 + 8 * c;
            if (d.f8) { u32x2 o; o.x = pk_fp8x4(q[0 * 33], q[1 * 33], q[2 * 33], q[3 * 33]); o.y = pk_fp8x4(q[4 * 33], q[5 * 33], q[6 * 33], q[7 * 33]); st8_wt(d.WT + eo, o); }
            else { u32x4 o; o.x = pk2(q[0 * 33], q[1 * 33]); o.y = pk2(q[2 * 33], q[3 * 33]); o.z = pk2(q[4 * 33], q[5 * 33]); o.w = pk2(q[6 * 33], q[7 * 33]); st16_wt(d.WT + 2 * eo, o); } }
        LDS_WAIT(); asm volatile("" ::: "memory");
        it = itn;
    }
}

__device__ __forceinline__ void norm_phase(const Ctx& X0, const float* xlat, const float* xctx, const float* shift0, const float* scale0, bf16_t* H, int rows) {
    const Ctx X = fresh(X0);
    const int gw = X.vcu * NWAVES + X.wave, NGW = X.G * NWAVES;
#define NP_V(m_) ((m_) < SEQ ? 0 : ((m_) < NLAT ? 1 : 2))
#define NP_SRC(m_) ((const GAS f32x4*)((m_) < NLAT ? xlat + (size_t)(m_) * D : xctx + (size_t)((m_) - NLAT) * D) + X.lane)
    for (int m0 = gw; m0 < rows; m0 += 4 * NGW) {
        const int ml = m0 + 3 * NGW, v0 = NP_V(m0);
        if (ml < rows && NP_V(ml) == v0) {
            f32x4 xv[4][4], sh[4], sc[4]; float s2[4];
#pragma unroll
            for (int r = 0; r < 4; ++r) { const int m = m0 + r * NGW; const GAS f32x4* xr = NP_SRC(m);
#pragma unroll
                for (int j = 0; j < 4; ++j) xv[r][j] = xr[64 * j]; }
            const f32x4* shp = (const f32x4*)(shift0 + (size_t)v0 * 6 * D) + X.lane; const f32x4* scp = (const f32x4*)(scale0 + (size_t)v0 * 6 * D) + X.lane;
#pragma unroll
            for (int j = 0; j < 4; ++j) { sh[j] = shp[64 * j]; sc[j] = scp[64 * j] + 1.f; }
#pragma unroll
            for (int r = 0; r < 4; ++r) { s2[r] = 0.f;
#pragma unroll
                for (int j = 0; j < 4; ++j) s2[r] += (xv[r][j].x * xv[r][j].x + xv[r][j].y * xv[r][j].y) + (xv[r][j].z * xv[r][j].z + xv[r][j].w * xv[r][j].w); }
#pragma unroll
            for (int r = 0; r < 4; ++r) s2[r] = 1.f / sqrtf(wave_sum(s2[r]) * (1.f / D) + EPS);
#pragma unroll
            for (int r = 0; r < 4; ++r) { GAS u32x2* o8 = (GAS u32x2*)(H + (size_t)(m0 + r * NGW) * D) + X.lane;
#pragma unroll
                for (int j = 0; j < 4; ++j) { const f32x4 h = xv[r][j] * s2[r] * sc[j] + sh[j];
                    u32x2 w; w.x = cvt_pk_bf16(h.x, h.y); w.y = cvt_pk_bf16(h.z, h.w); st8_wt((void*)(o8 + 64 * j), w); } }
        } else {
            for (int m = m0; m < rows && m <= ml; m += NGW) {
                const int v = NP_V(m);
                const GAS f32x4* xr = NP_SRC(m);
                const f32x4* shp = (const f32x4*)(shift0 + (size_t)v * 6 * D) + X.lane; const f32x4* scp = (const f32x4*)(scale0 + (size_t)v * 6 * D) + X.lane;
                f32x4 xv[4]; float s2 = 0.f;
#pragma unroll
                for (int j = 0; j < 4; ++j) { xv[j] = xr[64 * j]; s2 += (xv[j].x * xv[j].x + xv[j].y * xv[j].y) + (xv[j].z * xv[j].z + xv[j].w * xv[j].w); }
                const float rstd = 1.f / sqrtf(wave_sum(s2) * (1.f / D) + EPS);
                GAS u32x2* o8 = (GAS u32x2*)(H + (size_t)m * D) + X.lane;
#pragma unroll
                for (int j = 0; j < 4; ++j) { const f32x4 sh = shp[64 * j], sc = scp[64 * j]; const f32x4 h = xv[j] * rstd * (sc + 1.f) + sh;
                    u32x2 w; w.x = cvt_pk_bf16(h.x, h.y); w.y = cvt_pk_bf16(h.z, h.w); st8_wt((void*)(o8 + 64 * j), w); }
            }
        }
    }
#undef NP_V
#undef NP_SRC
}

__device__ __forceinline__ void conv_rows(const Ctx& X0, const bf16_t* QKV, bf16_t* CAT, const float* cw, int row0, int row1) {
    const Ctx X = fresh(X0);
    for (int it = row0 * 32 + X.tid; it < row1 * 32; it += NWAVES * 64) {
        const int m = it >> 5, c8 = (it & 31) * 8;
        int b, t, n, R;
        if (m < NLAT) { b = m >> 13; t = m & (SEQ - 1); n = SEQ; R = b * KVR + CTXL + t; } else { const int mm = m - NLAT; b = mm >> 8; t = mm & (CTXL - 1); n = CTXL; R = b * KVR + t; }
        float acc[8];
#pragma unroll
        for (int j = 0; j < 8; ++j) acc[j] = 0.f;
#pragma unroll
        for (int dt = -1; dt <= 1; ++dt) {
            if (t + dt < 0 || t + dt >= n) continue;
            const bf16_t* rp = QKV + (size_t)(R + dt) * INC;
            const bf16x8 xi = *(const bf16x8*)(rp + C_XIN + c8), cg = *(const bf16x8*)(rp + C_CG + c8);
            const float* w = cw + (dt + 1) * 256 + c8;
#pragma unroll
            for (int j = 0; j < 8; ++j) acc[j] += w[j] * (bf2f((unsigned short)xi[j]) * bf2f((unsigned short)cg[j]));
        }
        const bf16x8 bg = *(const bf16x8*)(QKV + (size_t)R * INC + C_BG + c8);
        u32x4 o;
        o.x = cvt_pk_bf16(acc[0] * bf2f((unsigned short)bg[0]), acc[1] * bf2f((unsigned short)bg[1])); o.y = cvt_pk_bf16(acc[2] * bf2f((unsigned short)bg[2]), acc[3] * bf2f((unsigned short)bg[3]));
        o.z = cvt_pk_bf16(acc[4] * bf2f((unsigned short)bg[4]), acc[5] * bf2f((unsigned short)bg[5])); o.w = cvt_pk_bf16(acc[6] * bf2f((unsigned short)bg[6]), acc[7] * bf2f((unsigned short)bg[7]));
        *(u32x4*)(CAT + (size_t)m * D + 768 + c8) = o;
    }
}

namespace att {
constexpr int KCH = 1040;
constexpr int KT_BYTES = 8 * KCH;
constexpr float THR = 8.f;
__device__ __forceinline__ int crow(int r, int hi) { return (r & 3) + 8 * (r >> 2) + 4 * hi; }
template <int W> __device__ __forceinline__ int v_st(int k, int c) { const int kk = (k & ~0xC) | ((k & 4) << 1) | ((k & 8) >> 1); return ((kk >> 3) * W + (c >> 5)) * 512 + ((kk & 7) * 32 + (c & 31)) * 2; }
template <int W> __device__ __forceinline__ int v_st_nat(int k, int c) { return ((k >> 3) * W + (c >> 5)) * 512 + ((k & 7) * 32 + (c & 31)) * 2; }
__device__ __forceinline__ int v_rd_base(int lane) { return ((lane & 3) << 3) | (((lane >> 2) & 3) << 6) | (((lane >> 4) & 1) << 5) | (((lane >> 5) & 1) << 8); }
template <int OFF> __device__ __forceinline__ s16x4 tr_read(int vb) { s16x4 r; asm volatile("ds_read_b64_tr_b16 %0, %1 offset:%2" : "=&v"(r) : "v"(vb), "i"(OFF) : "memory"); return r; }
template <int D0, int W> __device__ __forceinline__ void pv_one(f32x16& od, int vb, bf16x8 pa0, bf16x8 pa1, bf16x8 pa2, bf16x8 pa3) {
    constexpr int KS = W * 1024, HF = W * 512, B = D0 * 512;
    const s16x4 l0 = tr_read<B>(vb), h0 = tr_read<B + HF>(vb), l1 = tr_read<B + KS>(vb), h1 = tr_read<B + KS + HF>(vb);
    const s16x4 l2 = tr_read<B + 2 * KS>(vb), h2 = tr_read<B + 2 * KS + HF>(vb), l3 = tr_read<B + 3 * KS>(vb), h3 = tr_read<B + 3 * KS + HF>(vb);
    asm volatile("s_waitcnt lgkmcnt(0)" ::: "memory"); __builtin_amdgcn_sched_barrier(0);
#define ATT_PK(L, H) (bf16x8){L[0], L[1], L[2], L[3], H[0], H[1], H[2], H[3]}
    od = __builtin_amdgcn_mfma_f32_32x32x16_bf16(pa0, ATT_PK(l0, h0), od, 0, 0, 0);
    od = __builtin_amdgcn_mfma_f32_32x32x16_bf16(pa1, ATT_PK(l1, h1), od, 0, 0, 0);
    od = __builtin_amdgcn_mfma_f32_32x32x16_bf16(pa2, ATT_PK(l2, h2), od, 0, 0, 0);
    od = __builtin_amdgcn_mfma_f32_32x32x16_bf16(pa3, ATT_PK(l3, h3), od, 0, 0, 0);
#undef ATT_PK
}
__device__ __forceinline__ void qkt64(f32x16& p0, f32x16& p1, const LAS char* Ks, const bf16x8 (&qr)[4], int r32, int hi) {
    const LAS char* kb = Ks + hi * KCH + r32 * 16;
    p0 = (f32x16){}; p1 = (f32x16){};
#pragma unroll
    for (int d0 = 0; d0 < 4; ++d0) {
        const bf16x8 b0 = *(const LAS bf16x8*)(kb + d0 * 2 * KCH), b1 = *(const LAS bf16x8*)(kb + d0 * 2 * KCH + 512);
        p0 = __builtin_amdgcn_mfma_f32_32x32x16_bf16(b0, qr[d0], p0, 0, 0, 0);
        p1 = __builtin_amdgcn_mfma_f32_32x32x16_bf16(b1, qr[d0], p1, 0, 0, 0); }
}
__device__ __forceinline__ void qkt64s(f32x16& p0, f32x16& p1, const LAS char* kb, int kx, const bf16x8 (&qr)[4]) {
    p0 = (f32x16){}; p1 = (f32x16){};
#pragma unroll
    for (int d0 = 0; d0 < 4; ++d0) {
        const bf16x8 b0 = *(const LAS bf16x8*)(kb + (kx ^ (32 * d0))), b1 = *(const LAS bf16x8*)(kb + (kx ^ (32 * d0)) + 4096);
        p0 = __builtin_amdgcn_mfma_f32_32x32x16_bf16(b0, qr[d0], p0, 0, 0, 0);
        p1 = __builtin_amdgcn_mfma_f32_32x32x16_bf16(b1, qr[d0], p1, 0, 0, 0); }
}
__device__ __forceinline__ void softmax_tile(f32x16& p0, f32x16& p1, float& m_reg, float& l_reg, float& alpha, bf16x8& pa0, bf16x8& pa1, bf16x8& pa2, bf16x8& pa3) {
    float pmax = p0[0];
#pragma unroll
    for (int r = 1; r < 16; ++r) pmax = fmaxf(pmax, p0[r]);
#pragma unroll
    for (int r = 0; r < 16; ++r) pmax = fmaxf(pmax, p1[r]);
    { auto rr = __builtin_amdgcn_permlane32_swap(__float_as_uint(pmax), __float_as_uint(pmax), false, false); pmax = fmaxf(__uint_as_float(rr[0]), __uint_as_float(rr[1])); }
    float mn;
    if (__builtin_expect(__all(pmax - m_reg <= THR), 1)) { mn = m_reg; alpha = 1.f; }
    else { mn = fmaxf(m_reg, pmax); alpha = __builtin_amdgcn_exp2f(m_reg - mn); m_reg = mn; }
    float ps = 0.f;
#pragma unroll
    for (int r = 0; r < 16; ++r) { p0[r] = __builtin_amdgcn_exp2f(p0[r] - mn); ps += p0[r]; }
#pragma unroll
    for (int r = 0; r < 16; ++r) { p1[r] = __builtin_amdgcn_exp2f(p1[r] - mn); ps += p1[r]; }
    { auto rr = __builtin_amdgcn_permlane32_swap(__float_as_uint(ps), __float_as_uint(ps), false, false); ps = __uint_as_float(rr[0]) + __uint_as_float(rr[1]); }
    l_reg = l_reg * alpha + ps;
#define ATT_PK4(P, BASE, OUT) do { const unsigned a0 = cvt_pk_bf16(P[BASE + 0], P[BASE + 1]), a1 = cvt_pk_bf16(P[BASE + 2], P[BASE + 3]); \
    const unsigned b0 = cvt_pk_bf16(P[BASE + 4], P[BASE + 5]), b1 = cvt_pk_bf16(P[BASE + 6], P[BASE + 7]); \
    auto r0 = __builtin_amdgcn_permlane32_swap(a0, b0, false, false); auto r1 = __builtin_amdgcn_permlane32_swap(a1, b1, false, false); \
    u32x4 w = {r0[0], r1[0], r0[1], r1[1]}; OUT = __builtin_bit_cast(bf16x8, w); } while (0)
    ATT_PK4(p0, 0, pa0); ATT_PK4(p0, 8, pa1); ATT_PK4(p1, 0, pa2); ATT_PK4(p1, 8, pa3);
#undef ATT_PK4
}

template <bool CTXQ>
__device__ __forceinline__ void diff_unit_safe(const Ctx& X0, const bf16_t* QKV, bf16_t* CAT, int b, int hd, int qblk, float lam, const float* gain, float oscale) {
    const Ctx X = fresh(X0);
    constexpr int K_OFF = 0, V_OFF = 4 * KT_BYTES  , WS_OFF = V_OFF + 2 * 16384  ;
    const int tid = X.tid, lane = X.lane, wid = X.wave, r32 = lane & 31, hi = lane >> 5, jh = wid >> 2, qsub = wid & 3;
    LAS char* L = (LAS char*)X.lds;
    LAS float* wsf = (LAS float*)(L + WS_OFF) + wid * 64;
    const int NT = CTXQ ? CTXL / 64 : KVR / 64;
    const int kbase = b * KVR;
    const int qrow = b * KVR + (CTXQ ? 0 : CTXL) + qblk * 128 + qsub * 32 + r32;
    bf16x8 qr[4];
#pragma unroll
    for (int d0 = 0; d0 < 4; ++d0) qr[d0] = *(const bf16x8*)(QKV + (size_t)qrow * INC + C_QB + (2 * hd + jh) * 64 + d0 * 16 + hi * 8);
    const int khh = tid >> 8, kr = (tid >> 3) & 31, kc = tid & 7;
    const bf16_t* kg = QKV + (size_t)(kbase + kr) * INC + C_KB + (2 * hd + khh) * 64 + kc * 8;
    const int kl = K_OFF + khh * KT_BYTES + kc * KCH + kr * 16;
    const int sr = tid >> 4, sc = (tid & 15) * 8;
    const bf16_t* vg = QKV + (size_t)(kbase + sr) * INC + C_VB + hd * 128 + sc;
    const int vl0 = V_OFF + v_st<4>(sr, sc), vl1 = V_OFF + v_st<4>(32 + sr, sc);
    const int vb0 = (int)(uintptr_t)X.ldsg + V_OFF + v_rd_base(lane);
    const int ka0 = (int)(uintptr_t)X.ldsg + K_OFF + jh * KT_BYTES + hi * KCH + r32 * 16;
    bf16x8 ks0, ks1, vs0, vs1;
#define DF_SLOAD(t) do { const size_t go = (size_t)(t) * 64 * INC; ks0 = *(const bf16x8*)(kg + go); ks1 = *(const bf16x8*)(kg + go + 32 * INC); vs0 = *(const bf16x8*)(vg + go); vs1 = *(const bf16x8*)(vg + go + 32 * INC); } while (0)
#define DF_SWRITE(buf) do { *(LAS bf16x8*)(L + kl + (buf) * 2 * KT_BYTES) = ks0; *(LAS bf16x8*)(L + kl + (buf) * 2 * KT_BYTES + 512) = ks1; \
        *(LAS bf16x8*)(L + vl0 + (buf) * 16384) = vs0; *(LAS bf16x8*)(L + vl1 + (buf) * 16384) = vs1; } while (0)
    float m_reg = -1e30f, l_reg = 0.f; f32x16 o[4] = {};
    DF_SLOAD(0); VM_WAIT(); DF_SWRITE(0);
    for (int t = 0; t < NT; ++t) {
        const int buf = t & 1;
        __syncthreads();
        if (t + 1 < NT) DF_SLOAD(t + 1);
        float alpha; bf16x8 pa0, pa1, pa2, pa3;
        bf16x8 kf[8]; s16x4 vl[16], vh[16]; f32x16 p0 = {}, p1 = {};
        { const int ka = ka0 + buf * 2 * KT_BYTES, vb = vb0 + buf * 16384;
#pragma unroll
          for (int i = 0; i < 8; ++i) asm volatile("ds_read_b128 %0, %1 offset:%2" : "=&v"(kf[i]) : "v"(ka), "i"((i >> 1) * 2 * KCH + (i & 1) * 512) : "memory");
#define DF_VRD(i) do { asm volatile("ds_read_b64_tr_b16 %0, %1 offset:%2" : "=&v"(vl[i]) : "v"(vb), "i"(((i) >> 2) * 512 + ((i) & 3) * 4096) : "memory"); \
                       asm volatile("ds_read_b64_tr_b16 %0, %1 offset:%2" : "=&v"(vh[i]) : "v"(vb), "i"(((i) >> 2) * 512 + ((i) & 3) * 4096 + 2048) : "memory"); } while (0)
#pragma unroll
          for (int i = 0; i < 7; ++i) DF_VRD(i);
          asm volatile("s_waitcnt lgkmcnt(14)" ::: "memory"); __builtin_amdgcn_sched_barrier(0);
#pragma unroll
          for (int d0 = 0; d0 < 4; ++d0) { p0 = __builtin_amdgcn_mfma_f32_32x32x16_bf16(kf[2 * d0], qr[d0], p0, 0, 0, 0); p1 = __builtin_amdgcn_mfma_f32_32x32x16_bf16(kf[2 * d0 + 1], qr[d0], p1, 0, 0, 0); }
#pragma unroll
          for (int i = 7; i < 16; ++i) DF_VRD(i);
#undef DF_VRD
        }
        softmax_tile(p0, p1, m_reg, l_reg, alpha, pa0, pa1, pa2, pa3);
        if (__any(alpha < 1.f)) { if (hi == 0) wsf[r32] = alpha; LDS_WAIT();
#pragma unroll
            for (int d = 0; d < 4; ++d)
#pragma unroll
                for (int r = 0; r < 16; ++r) o[d][r] *= wsf[crow(r, hi)]; }
        asm volatile("s_waitcnt lgkmcnt(0)" ::: "memory"); __builtin_amdgcn_sched_barrier(0);
#define DF_PK(i) (bf16x8){vl[i][0], vl[i][1], vl[i][2], vl[i][3], vh[i][0], vh[i][1], vh[i][2], vh[i][3]}
#pragma unroll
        for (int d0 = 0; d0 < 4; ++d0) {
            o[d0] = __builtin_amdgcn_mfma_f32_32x32x16_bf16(pa0, DF_PK(d0 * 4 + 0), o[d0], 0, 0, 0); o[d0] = __builtin_amdgcn_mfma_f32_32x32x16_bf16(pa1, DF_PK(d0 * 4 + 1), o[d0], 0, 0, 0);
            o[d0] = __builtin_amdgcn_mfma_f32_32x32x16_bf16(pa2, DF_PK(d0 * 4 + 2), o[d0], 0, 0, 0); o[d0] = __builtin_amdgcn_mfma_f32_32x32x16_bf16(pa3, DF_PK(d0 * 4 + 3), o[d0], 0, 0, 0); }
#undef DF_PK
        if (t + 1 < NT) { VM_WAIT(); DF_SWRITE(buf ^ 1); }
    }
#undef DF_SLOAD
#undef DF_SWRITE
    if (hi == 0) wsf[32 + r32] = l_reg; LDS_WAIT();
    float rli[16];
#pragma unroll
    for (int r = 0; r < 16; ++r) rli[r] = __builtin_amdgcn_rcpf(wsf[32 + crow(r, hi)]);
#pragma unroll
    for (int d = 0; d < 4; ++d)
#pragma unroll
        for (int r = 0; r < 16; ++r) o[d][r] *= rli[r];
    __syncthreads();
    LAS float* XO = (LAS float*)L + qsub * 4096;
    if (jh == 1) {
#pragma unroll
        for (int d = 0; d < 4; ++d)
#pragma unroll
            for (int r = 0; r < 16; ++r) XO[crow(r, hi) * 128 + d * 32 + r32] = o[d][r];
    }
    __syncthreads();
    if (jh == 0) {
        float ss[16];
#pragma unroll
        for (int r = 0; r < 16; ++r) { float s = 0.f;
#pragma unroll
            for (int d = 0; d < 4; ++d) { const float v = o[d][r] - lam * XO[crow(r, hi) * 128 + d * 32 + r32]; o[d][r] = v; s += v * v; }
            ss[r] = s; }
#pragma unroll
        for (int r = 0; r < 16; ++r) {
#pragma unroll
            for (int off = 1; off < 32; off <<= 1) ss[r] += __shfl_xor(ss[r], off);
            ss[r] = oscale / sqrtf(ss[r] * (1.f / 128.f) + EPS); }
        const int orow0 = (CTXQ ? NLAT + b * CTXL : b * SEQ) + qblk * 128 + qsub * 32;
#pragma unroll
        for (int d = 0; d < 4; ++d) { const float g = gain[d * 32 + r32];
#pragma unroll
            for (int r = 0; r < 16; ++r) CAT[(size_t)(orow0 + crow(r, hi)) * D + 256 + hd * 128 + d * 32 + r32] = (bf16_t)f2bf(o[d][r] * ss[r] * g); }
    }
    __syncthreads();
}

template <bool CTXQ>
__device__ __forceinline__ void diff_unit_fast(const Ctx& X0, const bf16_t* QKV, bf16_t* CAT, int b, int hd, int qblk, float lam, const float* gain, float oscale) {
    const Ctx X = fresh(X0);
    constexpr int K_OFF = 0, V_OFF = 4 * KT_BYTES  , WS_OFF = V_OFF + 2 * 16384  ;
    const int tid = X.tid, lane = X.lane, wid = X.wave, r32 = lane & 31, hi = lane >> 5, jh = wid >> 2, qsub = wid & 3;
    LAS char* L = (LAS char*)X.lds;
    LAS float* wsf = (LAS float*)(L + WS_OFF) + wid * 64;
    const int NT = CTXQ ? CTXL / 64 : KVR / 64;
    const int kbase = b * KVR;
    const int qrow = b * KVR + (CTXQ ? 0 : CTXL) + qblk * 128 + qsub * 32 + r32;
    bf16x8 qr[4];
#pragma unroll
    for (int d0 = 0; d0 < 4; ++d0) qr[d0] = *(const bf16x8*)(QKV + (size_t)qrow * INC + C_QB + (2 * hd + jh) * 64 + d0 * 16 + hi * 8);
    const int khh = tid >> 8, kr = (tid >> 3) & 31, kc = tid & 7;
    const bf16_t* kg = QKV + (size_t)(kbase + kr) * INC + C_KB + (2 * hd + khh) * 64 + kc * 8;
    const int kl = K_OFF + khh * KT_BYTES + kc * KCH + kr * 16;
    const int sr = tid >> 4, sc = (tid & 15) * 8;
    const bf16_t* vg_ = QKV + (size_t)(kbase + sr) * INC + C_VB + hd * 128 + sc; const bf16_t* vg = vg_;
    const int vl0 = V_OFF + v_st_nat<4>(sr, sc), vl1 = V_OFF + v_st_nat<4>(32 + sr, sc);
    const int vb0 = (int)(uintptr_t)X.ldsg + V_OFF + v_rd_base(lane);
    const int ka0 = (int)(uintptr_t)X.ldsg + K_OFF + jh * KT_BYTES + hi * KCH + r32 * 16;
    bf16x8 ks0, ks1, vs0, vs1;
#define DF_SLOAD(t) do { ks0 = *(const bf16x8*)(kg); ks1 = *(const bf16x8*)(kg + 32 * INC); vs0 = *(const bf16x8*)(vg); vs1 = *(const bf16x8*)(vg + 32 * INC); kg += 64 * INC; vg += 64 * INC; } while (0)
#define DF_SWRITE(buf) do { *(LAS bf16x8*)(L + kl + (buf) * 2 * KT_BYTES) = ks0; *(LAS bf16x8*)(L + kl + (buf) * 2 * KT_BYTES + 512) = ks1; \
        *(LAS bf16x8*)(L + vl0 + (buf) * 16384) = vs0; *(LAS bf16x8*)(L + vl1 + (buf) * 16384) = vs1; } while (0)
    float l_reg = 0.f; f32x16 o[4] = {};
    u32x4 negm_w = {0u, 0u, 0u, 0u}; const u32x4 ones_w = {hi == 0 ? 0x3F80u : 0u, 0u, 0u, 0u};
    LAS unsigned* flagp = (LAS unsigned*)(L + WS_OFF) + 8 * 64;
    if (tid == 0) *flagp = 0u;
    DF_SLOAD(0); VM_WAIT(); DF_SWRITE(0);
    __syncthreads();
    { f32x16 p0, p1; qkt64(p0, p1, L + K_OFF + jh * KT_BYTES, qr, r32, hi);
      float pmax = p0[0];
#pragma unroll
      for (int r = 1; r < 16; ++r) pmax = fmaxf(pmax, p0[r]);
#pragma unroll
      for (int r = 0; r < 16; ++r) pmax = fmaxf(pmax, p1[r]);
      { auto rr = __builtin_amdgcn_permlane32_swap(__float_as_uint(pmax), __float_as_uint(pmax), false, false); pmax = fmaxf(__uint_as_float(rr[0]), __uint_as_float(rr[1])); }
      negm_w.x = hi == 0 ? f2bf(-pmax) : 0u; }
    const bf16x8 negm_f = __builtin_bit_cast(bf16x8, negm_w), ones_f = __builtin_bit_cast(bf16x8, ones_w);
#pragma unroll 1
    for (int t = 0; t < NT; ++t) {
        const int buf = t & 1;
        __syncthreads();
        if (t + 1 < NT) DF_SLOAD(t + 1);
        bf16x8 pa0, pa1, pa2, pa3;
        bf16x8 kf[8]; s16x4 vl[16], vh[16]; f32x16 p0, p1;
        { const int ka = ka0 + buf * 2 * KT_BYTES, vb = vb0 + buf * 16384;
#pragma unroll
          for (int i = 0; i < 8; ++i) asm volatile("ds_read_b128 %0, %1 offset:%2" : "=&v"(kf[i]) : "v"(ka), "i"((i >> 1) * 2 * KCH + (i & 1) * 512) : "memory");
#define DF_VRD(i) do { asm volatile("ds_read_b64_tr_b16 %0, %1 offset:%2" : "=&v"(vl[i]) : "v"(vb), "i"(((i) >> 2) * 512 + ((i) & 3) * 4096) : "memory"); \
                       asm volatile("ds_read_b64_tr_b16 %0, %1 offset:%2" : "=&v"(vh[i]) : "v"(vb), "i"(((i) >> 2) * 512 + ((i) & 3) * 4096 + 2048) : "memory"); } while (0)
#pragma unroll
          for (int i = 0; i < 7; ++i) DF_VRD(i);
          { bf16x8 on_ = ones_f; asm volatile("" : "+v"(on_));
            p0 = __builtin_amdgcn_mfma_f32_32x32x16_bf16(on_, negm_f, (f32x16){}, 0, 0, 0); asm volatile("" : "+v"(on_)); p1 = __builtin_amdgcn_mfma_f32_32x32x16_bf16(on_, negm_f, (f32x16){}, 0, 0, 0); }
          __builtin_amdgcn_sched_barrier(0);
          asm volatile("s_waitcnt lgkmcnt(14)" ::: "memory"); __builtin_amdgcn_sched_barrier(0);
#pragma unroll
          for (int d0 = 0; d0 < 4; ++d0) { p0 = __builtin_amdgcn_mfma_f32_32x32x16_bf16(kf[2 * d0], qr[d0], p0, 0, 0, 0); p1 = __builtin_amdgcn_mfma_f32_32x32x16_bf16(kf[2 * d0 + 1], qr[d0], p1, 0, 0, 0); }
#pragma unroll
          for (int i = 7; i < 16; ++i) DF_VRD(i);
#undef DF_VRD
        }
        { float sa = 0.f, sb = 0.f, sc_ = 0.f, sd = 0.f;
#pragma unroll
          for (int r = 0; r < 16; r += 2) { p0[r] = __builtin_amdgcn_exp2f(p0[r]); p0[r + 1] = __builtin_amdgcn_exp2f(p0[r + 1]); sa += p0[r]; sb += p0[r + 1]; }
#pragma unroll
          for (int r = 0; r < 16; r += 2) { p1[r] = __builtin_amdgcn_exp2f(p1[r]); p1[r + 1] = __builtin_amdgcn_exp2f(p1[r + 1]); sc_ += p1[r]; sd += p1[r + 1]; }
          l_reg += (sa + sb) + (sc_ + sd); asm volatile("" : "+v"(l_reg)); }
#define ATT_PKN(P, BASE, OUT) do { u32x4 w; w.x = cvt_pk_bf16(P[BASE + 0], P[BASE + 1]); w.y = cvt_pk_bf16(P[BASE + 2], P[BASE + 3]); w.z = cvt_pk_bf16(P[BASE + 4], P[BASE + 5]); w.w = cvt_pk_bf16(P[BASE + 6], P[BASE + 7]); \
    OUT = __builtin_bit_cast(bf16x8, w); } while (0)
        ATT_PKN(p0, 0, pa0); ATT_PKN(p0, 8, pa1); ATT_PKN(p1, 0, pa2); ATT_PKN(p1, 8, pa3);
#undef ATT_PKN
        asm volatile("s_waitcnt lgkmcnt(0)" ::: "memory"); __builtin_amdgcn_sched_barrier(0);
#define DF_PK(i) (bf16x8){vl[i][0], vl[i][1], vl[i][2], vl[i][3], vh[i][0], vh[i][1], vh[i][2], vh[i][3]}
#pragma unroll
        for (int d0 = 0; d0 < 4; ++d0) {
            o[d0] = __builtin_amdgcn_mfma_f32_32x32x16_bf16(pa0, DF_PK(d0 * 4 + 0), o[d0], 0, 0, 0); o[d0] = __builtin_amdgcn_mfma_f32_32x32x16_bf16(pa1, DF_PK(d0 * 4 + 1), o[d0], 0, 0, 0);
            o[d0] = __builtin_amdgcn_mfma_f32_32x32x16_bf16(pa2, DF_PK(d0 * 4 + 2), o[d0], 0, 0, 0); o[d0] = __builtin_amdgcn_mfma_f32_32x32x16_bf16(pa3, DF_PK(d0 * 4 + 3), o[d0], 0, 0, 0); }
#undef DF_PK
        if (t + 1 < NT) { VM_WAIT(); DF_SWRITE(buf ^ 1); }
    }
#undef DF_SLOAD
#undef DF_SWRITE
    { auto rr = __builtin_amdgcn_permlane32_swap(__float_as_uint(l_reg), __float_as_uint(l_reg), false, false); l_reg = __uint_as_float(rr[0]) + __uint_as_float(rr[1]); }
    if (__any(!(l_reg < 1.0e30f)) && lane == 0) *flagp = 1u;
    if (hi == 0) wsf[32 + r32] = l_reg; LDS_WAIT();
    float rli[16];
#pragma unroll
    for (int r = 0; r < 16; ++r) rli[r] = __builtin_amdgcn_rcpf(wsf[32 + crow(r, hi)]);
#pragma unroll
    for (int d = 0; d < 4; ++d)
#pragma unroll
        for (int r = 0; r < 16; ++r) o[d][r] *= rli[r];
    __syncthreads();
    const bool redo = *flagp != 0u;
    LAS float* XO = (LAS float*)L + qsub * 4096;
    if (jh == 1) {
#pragma unroll
        for (int d = 0; d < 4; ++d)
#pragma unroll
            for (int r = 0; r < 16; ++r) XO[crow(r, hi) * 128 + d * 32 + r32] = o[d][r];
    }
    __syncthreads();
    if (jh == 0) {
        float ss[16];
#pragma unroll
        for (int r = 0; r < 16; ++r) { float s = 0.f;
#pragma unroll
            for (int d = 0; d < 4; ++d) { const float v = o[d][r] - lam * XO[crow(r, hi) * 128 + d * 32 + r32]; o[d][r] = v; s += v * v; }
            ss[r] = s; }
#pragma unroll
        for (int r = 0; r < 16; ++r) {
#pragma unroll
            for (int off = 1; off < 32; off <<= 1) ss[r] += __shfl_xor(ss[r], off);
            ss[r] = oscale / sqrtf(ss[r] * (1.f / 128.f) + EPS); }
        const int orow0 = (CTXQ ? NLAT + b * CTXL : b * SEQ) + qblk * 128 + qsub * 32;
#pragma unroll
        for (int d = 0; d < 4; ++d) { const float g = gain[d * 32 + r32];
#pragma unroll
            for (int r = 0; r < 16; ++r) CAT[(size_t)(orow0 + crow(r, hi)) * D + 256 + hd * 128 + d * 32 + r32] = (bf16_t)f2bf(o[d][r] * ss[r] * g); }
    }
    __syncthreads();
    if (redo) diff_unit_safe<CTXQ>(X0, QKV, CAT, b, hd, qblk, lam, gain, oscale);
}

template <bool CTXQ>
__device__ __forceinline__ void na_unit(const Ctx& X0, const bf16_t* QKV, bf16_t* CAT, const float* rpb  , int b, int h, int r0) {
    const Ctx X = fresh(X0);
    constexpr int K_OFF = 0, V_OFF = 16896, RPB_OFF = V_OFF + 2 * 8192  , WS_OFF = RPB_OFF + 2048;
    const int tid = X.tid, lane = X.lane, wid = X.wave, r32 = lane & 31, hi = lane >> 5;
    LAS char* L = (LAS char*)X.lds;
    LAS float* wsf = (LAS float*)(L + WS_OFF) + wid * 64;
    LAS float* rpbL = (LAS float*)(L + RPB_OFF);
    const int kbase = b * KVR;
    int kr_lo = 0, nlat = 0, r = 0, qc = 0, rs = 0, qrow, orow;
    if (CTXQ) { qrow = kbase + wid * 32 + r32; orow = NLAT + b * CTXL + wid * 32; }
    else {
        kr_lo = min(max(r0 - 4, 0), GROWS - 8); const int kr_hi = min(max(r0 + 3 - 4, 0), GROWS - 8) + 8; nlat = kr_hi - kr_lo;
        r = r0 + (wid >> 1); qc = 32 * (wid & 1) + r32; rs = min(max(r - 4, 0), GROWS - 8);
        qrow = kbase + CTXL + r * GRIDW + qc; orow = b * SEQ + r * GRIDW + 32 * (wid & 1);
        for (int i = tid; i < 15 * 31; i += NWAVES * 64) rpbL[i] = rpb[i] * LOG2E;
    }
    const int NT = nlat + CTXL / 64;
    bf16x8 qr[4];
#pragma unroll
    for (int d0 = 0; d0 < 4; ++d0) qr[d0] = *(const bf16x8*)(QKV + (size_t)qrow * INC + C_QA + h * 64 + d0 * 16 + hi * 8);
    const int srow = tid >> 3, sc8 = tid & 7;
    const bf16_t* kg = QKV + (size_t)kbase * INC + C_KA + h * 64 + sc8 * 8;
    const bf16_t* vg = QKV + (size_t)kbase * INC + C_VA + h * 64 + sc8 * 8;
    const int kl = K_OFF + sc8 * KCH + srow * 16, vl = V_OFF + v_st<2>(srow, sc8 * 8);
    const int vb0 = (int)(uintptr_t)X.ldsg + V_OFF + v_rd_base(lane);
    bf16x8 ks, vs;
#define NA_TROW(t) ((t) < nlat ? CTXL + (kr_lo + (t)) * GRIDW : ((t) - nlat) * 64)
#define NA_SLOAD(t) do { const size_t go = (size_t)(NA_TROW(t) + srow) * INC; ks = *(const bf16x8*)(kg + go); vs = *(const bf16x8*)(vg + go); } while (0)
#define NA_SWRITE(buf) do { *(LAS bf16x8*)(L + kl + (buf) * KT_BYTES) = ks; *(LAS bf16x8*)(L + vl + (buf) * 8192) = vs; } while (0)
    float m_reg = -1e30f, l_reg = 0.f; f32x16 o[2] = {};
    const int ws = min(max(qc - 8, 0), GRIDW - 16);
    NA_SLOAD(0); VM_WAIT(); NA_SWRITE(0);
    for (int t = 0; t < NT; ++t) {
        const int buf = t & 1;
        __syncthreads();
        if (t + 1 < NT) NA_SLOAD(t + 1);
        const bool lat_tile = t < nlat;
        const int drow = kr_lo + t - r + 7;
        const bool active = !lat_tile || (unsigned)(kr_lo + t - rs) < 8u;
        if (active) {
            f32x16 p0, p1; float alpha; bf16x8 pa0, pa1, pa2, pa3;
            qkt64(p0, p1, L + K_OFF + buf * KT_BYTES, qr, r32, hi);
            if (lat_tile) {
                const LAS float* bp = rpbL + drow * 31 + 15 - qc;
#pragma unroll
                for (int rr = 0; rr < 16; ++rr) { const int k0 = crow(rr, hi), k1 = k0 + 32;
                    const bool v0 = (unsigned)(k0 - ws) < 16u, v1 = (unsigned)(k1 - ws) < 16u;
                    const float b0 = bp[v0 ? k0 : qc], b1 = bp[v1 ? k1 : qc];
                    p0[rr] = v0 ? p0[rr] + b0 : -1e30f; p1[rr] = v1 ? p1[rr] + b1 : -1e30f; }
            }
            softmax_tile(p0, p1, m_reg, l_reg, alpha, pa0, pa1, pa2, pa3);
            if (__any(alpha < 1.f)) { if (hi == 0) wsf[r32] = alpha; LDS_WAIT();
#pragma unroll
                for (int d = 0; d < 2; ++d)
#pragma unroll
                    for (int rr = 0; rr < 16; ++rr) o[d][rr] *= wsf[crow(rr, hi)]; }
            const int vb = vb0 + buf * 8192;
            pv_one<0, 2>(o[0], vb, pa0, pa1, pa2, pa3); pv_one<1, 2>(o[1], vb, pa0, pa1, pa2, pa3);
        }
        if (t + 1 < NT) { VM_WAIT(); NA_SWRITE(buf ^ 1); }
    }
#undef NA_TROW
#undef NA_SLOAD
#undef NA_SWRITE
    if (hi == 0) wsf[32 + r32] = l_reg; LDS_WAIT();
#pragma unroll
    for (int rr = 0; rr < 16; ++rr) { const float rl = __builtin_amdgcn_rcpf(wsf[32 + crow(rr, hi)]);
#pragma unroll
        for (int d = 0; d < 2; ++d) CAT[(size_t)(orow + crow(rr, hi)) * D + h * 64 + d * 32 + r32] = (bf16_t)f2bf(o[d][rr] * rl); }
    __syncthreads();
}
}

__device__ __forceinline__ void moe_route_phase(const Ctx& X0, const float* xlat, const float* shift0, const float* scale0, const float* router_w, unsigned char* H8) {
    const Ctx X = fresh(X0);
    LAS float* WrT = (LAS float*)X.lds;
    LAS int* pe = (LAS int*)(X.lds + 32768);
    LAS int* psl = pe + 512;
    LAS int* lcnt = psl + 512;
    LAS int* gbase = lcnt + 8;
    int* tokl = (int*)(X.ws + WS_TOKL); unsigned* tinfo = (unsigned*)(X.ws + WS_TINFO);
    for (int i = X.tid; i < D * NEXP; i += NWAVES * 64) WrT[(i & 7) * D + (i >> 3)] = router_w[i];
    if (X.tid < 8) lcnt[X.tid] = 0;
    __syncthreads();
    const int gw = X.vcu * NWAVES + X.wave, NGW = X.G * NWAVES;
    int nr = 0;
    for (int m = gw; m < NLAT && nr < 32; m += NGW, ++nr) {
        const int v = m < SEQ ? 0 : 1;
        const GAS f32x4* xr = (const GAS f32x4*)(xlat + (size_t)m * D) + X.lane;
        const f32x4* shp = (const f32x4*)(shift0 + (size_t)v * 6 * D) + X.lane; const f32x4* scp = (const f32x4*)(scale0 + (size_t)v * 6 * D) + X.lane;
        f32x4 xv[4]; float s2 = 0.f;
#pragma unroll
        for (int j = 0; j < 4; ++j) { xv[j] = xr[64 * j]; s2 += (xv[j].x * xv[j].x + xv[j].y * xv[j].y) + (xv[j].z * xv[j].z + xv[j].w * xv[j].w); }
        const float rstd = 1.f / sqrtf(wave_sum(s2) * (1.f / D) + EPS);
        GAS unsigned* o4 = (GAS unsigned*)(H8 + (size_t)m * D) + X.lane;
        float lg[8];
#pragma unroll
        for (int e = 0; e < 8; ++e) lg[e] = 0.f;
#pragma unroll
        for (int j = 0; j < 4; ++j) { const f32x4 sh = shp[64 * j], sc = scp[64 * j]; const f32x4 h = xv[j] * rstd * (sc + 1.f) + sh;
            o4[64 * j] = pk_fp8x4(h.x, h.y, h.z, h.w);
#pragma unroll
            for (int e = 0; e < 8; ++e) { const f32x4 wr = *(const LAS f32x4*)(WrT + e * D + 256 * j + 4 * X.lane); lg[e] += (h.x * wr.x + h.y * wr.y) + (h.z * wr.z + h.w * wr.w); } }
#pragma unroll
        for (int e = 0; e < 8; ++e) lg[e] = wave_sum(lg[e]);
        int i1 = 0; float v1 = lg[0];
#pragma unroll
        for (int e = 1; e < 8; ++e) if (lg[e] > v1) { v1 = lg[e]; i1 = e; }
        int i2 = -1; float v2 = -3.0e38f;
#pragma unroll
        for (int e = 0; e < 8; ++e) if (e != i1 && lg[e] > v2) { v2 = lg[e]; i2 = e; }
        const float g1 = 1.f / (1.f + __expf(v2 - v1)), g2 = 1.f - g1;
        if (X.lane == 0) {
            const int s1 = __hip_atomic_fetch_add(lcnt + i1, 1, __ATOMIC_RELAXED, __HIP_MEMORY_SCOPE_WORKGROUP);
            const int s2_ = __hip_atomic_fetch_add(lcnt + i2, 1, __ATOMIC_RELAXED, __HIP_MEMORY_SCOPE_WORKGROUP);
            const int pi = (X.wave * 32 + nr) * 2; pe[pi] = i1; pe[pi + 1] = i2; psl[pi] = s1; psl[pi + 1] = s2_;
            unsigned* ti = tinfo + (size_t)m * 8; ti[4] = __float_as_uint(g1); ti[5] = __float_as_uint(g2);
        }
    }
    __syncthreads();
    if (X.tid < 8) gbase[X.tid] = (int)__hip_atomic_fetch_add((unsigned*)(X.ctl + CW_ECNT + 64 * X.tid), (unsigned)lcnt[X.tid], RLX_AGENT);
    __syncthreads();
    if (X.lane < 2 * nr) {
        const int i = X.lane >> 1, k = X.lane & 1, pi = (X.wave * 32 + i) * 2 + k, m = gw + i * NGW;
        const int e = pe[pi], slot = gbase[e] + psl[pi];
        tokl[e * 16384 + slot] = m;
        unsigned* ti = tinfo + (size_t)m * 8; ti[2 * k] = (unsigned)e; ti[2 * k + 1] = (unsigned)slot;
    }
    __syncthreads();
}
__device__ __forceinline__ int moe_setup(const Ctx& X0) {
    const Ctx X = fresh(X0);
    if (X.tid == 0) { unsigned pre = 0;
        for (int e = 0; e < NEXP; ++e) { unsigned c = __hip_atomic_load((unsigned*)(X.ctl + CW_ECNT + 64 * e), RLX_AGENT); if (c > 16384u) c = 16384u; X.MISC[16 + e] = pre; X.MISC[32 + e] = c; pre += (c + 255u) >> 8; }
        X.MISC[16 + NEXP] = pre > (unsigned)MOE_MAXP ? (unsigned)MOE_MAXP : pre; }
    __syncthreads();
    return (int)X.MISC[16 + NEXP];
}
__device__ __forceinline__ void final_phase(const Ctx& X0, float* xlat, const bf16_t* Y, const float* gf0, const float* fgain) {
    const Ctx X = fresh(X0);
    const unsigned* tinfo = (const unsigned*)(X.ws + WS_TINFO);
    const int gw = X.vcu * NWAVES + X.wave, NGW = X.G * NWAVES;
    for (int m = gw; m < NLAT; m += NGW) {
        const int v = m < SEQ ? 0 : 1;
        const unsigned* ti = tinfo + (size_t)m * 8;
        const int e1 = (int)ti[0], s1 = (int)ti[1], e2 = (int)ti[2], s2 = (int)ti[3]; const float g1 = __uint_as_float(ti[4]), g2 = __uint_as_float(ti[5]);
        const size_t y1 = (size_t)((int)X.MISC[16 + e1] * 256 + s1), y2 = (size_t)((int)X.MISC[16 + e2] * 256 + s2);
        GAS f32x4* xr = (GAS f32x4*)(xlat + (size_t)m * D) + X.lane;
        const bf16_t* Yt = (const bf16_t*)(X.ws + WS_YT);
        f32x4 ya[4], yb[4];
        if (y1 < 32768) {
#pragma unroll
            for (int j = 0; j < 4; ++j) { const u32x2 w = ((const u32x2*)(Y + y1 * D) + X.lane)[64 * j]; ya[j] = (f32x4){__uint_as_float(w.x << 16), __uint_as_float(w.x & 0xffff0000u), __uint_as_float(w.y << 16), __uint_as_float(w.y & 0xffff0000u)}; }
        } else {
#pragma unroll
            for (int j = 0; j < 4; ++j) { ya[j] = (f32x4){0.f, 0.f, 0.f, 0.f};
#pragma unroll
                for (int sl = 0; sl < 7; ++sl) { const u32x2 w = ((const u32x2*)(Yt + ((size_t)sl * 2048 + (y1 - 32768)) * D) + X.lane)[64 * j];
                    ya[j] += (f32x4){__uint_as_float(w.x << 16), __uint_as_float(w.x & 0xffff0000u), __uint_as_float(w.y << 16), __uint_as_float(w.y & 0xffff0000u)}; } }
        }
        if (y2 < 32768) {
#pragma unroll
            for (int j = 0; j < 4; ++j) { const u32x2 w = ((const u32x2*)(Y + y2 * D) + X.lane)[64 * j]; yb[j] = (f32x4){__uint_as_float(w.x << 16), __uint_as_float(w.x & 0xffff0000u), __uint_as_float(w.y << 16), __uint_as_float(w.y & 0xffff0000u)}; }
        } else {
#pragma unroll
            for (int j = 0; j < 4; ++j) { yb[j] = (f32x4){0.f, 0.f, 0.f, 0.f};
#pragma unroll
                for (int sl = 0; sl < 7; ++sl) { const u32x2 w = ((const u32x2*)(Yt + ((size_t)sl * 2048 + (y2 - 32768)) * D) + X.lane)[64 * j];
                    yb[j] += (f32x4){__uint_as_float(w.x << 16), __uint_as_float(w.x & 0xffff0000u), __uint_as_float(w.y << 16), __uint_as_float(w.y & 0xffff0000u)}; } }
        }
        const f32x4* gp = (const f32x4*)(gf0 + (size_t)v * 6 * D) + X.lane; const f32x4* fg = (const f32x4*)fgain + X.lane;
        f32x4 xv[4]; float ss = 0.f;
#pragma unroll
        for (int j = 0; j < 4; ++j) { xv[j] = xr[64 * j] + gp[64 * j] * (ya[j] * g1 + yb[j] * g2); ss += (xv[j].x * xv[j].x + xv[j].y * xv[j].y) + (xv[j].z * xv[j].z + xv[j].w * xv[j].w); }
        const float rstd = 1.f / sqrtf(wave_sum(ss) * (1.f / D) + EPS);
#pragma unroll
        for (int j = 0; j < 4; ++j) xr[64 * j] = xv[j] * rstd * fg[64 * j];
    }
}

constexpr int N_PHASES = 16;
constexpr int N_LAUNCHES = MK_N_LAUNCHES;
__global__ void __launch_bounds__(NWAVES * 64, 2) fwd(Params P) {
    extern __shared__ __attribute__((aligned(16))) unsigned char lds[];
    Ctx X;
    X.lds = (LAS unsigned char*)lds; X.ldsg = (char*)lds;
    X.MISC = (volatile LAS unsigned*)(X.lds + MISC_OFF);
    X.tid = threadIdx.x; X.lane = X.tid & 63; X.wave = __builtin_amdgcn_readfirstlane(X.tid >> 6);
    X.G = gridDim.x; { const int bx = blockIdx.x; X.vcu = (X.G % 8 == 0) ? (bx % 8) * (X.G / 8) + bx / 8 : bx; }
    X.ws = P.ws; X.ctl = (gu32*)(P.ws + WS_CTL);
    for (int u = X.tid; u < (LDS_BYTES - RING_BYTES) / 4; u += NWAVES * 64) ((LAS unsigned*)(X.lds + RING_BYTES))[u] = 0u;
    __syncthreads();
    XcdBarrier bar; bar.bar = (unsigned*)(X.ctl + CW_BAR); bar.x = 0; bar.st = nullptr;
    if (N_LAUNCHES != N_PHASES) bar = xcd_barrier_post((unsigned*)(X.ctl + CW_BAR), X.MISC + 8);
#define GRID_BAR() do { if (N_LAUNCHES == N_PHASES) { if (X.tid == 0) __hip_atomic_store(X.ctl + CW_TMO, 0xBADBA0u, RLX_AGENT); } else { xcd_barrier(bar); } } while (0)
    const int lo = P.ph_lo, hi = P.ph_hi;
#ifndef PH_MASK
#define PH_MASK 0xFFFF
#endif
#define IN(k) (((PH_MASK >> (k)) & 1) && lo <= (k) && (k) < hi)
#ifndef REP_MASK
#define REP_MASK 0
#endif
#define REPS(k) (((REP_MASK >> (k)) & 1) ? 2 : 1)
#define BOTH(k) (IN(k) && IN((k) + 1))
#define LIN(j) (((PH_MASK >> (1 + (j))) & 1) && lo <= (pb + (j)) && (pb + (j)) < hi)
#define LBOTH(j) (LIN(j) && lo <= (pb + (j) + 1) && (pb + (j) + 1) < hi)
    unsigned char* ws = P.ws;
    bf16_t* H = (bf16_t*)(ws + WS_H); bf16_t* QKV = (bf16_t*)(ws + WS_QKV); bf16_t* CAT = (bf16_t*)(ws + WS_CAT); bf16_t* HID = (bf16_t*)(ws + WS_HID);
    float* XCTX = (float*)(ws + WS_XCTX);

    if (IN(0)) { for (int rep = 0; rep < REPS(0); ++rep) { p0_prologue(X, P); if (rep + 1 < REPS(0)) GRID_BAR(); } if (BOTH(0)) GRID_BAR(); }

    for (int Lr = 0; Lr < 2; ++Lr) {
        const int L = __builtin_amdgcn_readfirstlane(Lr);
        const int pb = 1 + 7 * L;
        const float* xl = L == 0 ? P.x : P.out; const float* xc = L == 0 ? P.ctx : XCTX;
        if (LIN(0)) { norm_phase(X, xl, xc, modp(X, L, 0, 0), modp(X, L, 0, 1), H, MROWS); if (LBOTH(0)) GRID_BAR(); }
        if (LIN(1)) {
            SchedPlain S; S.T.init(NLAT / 256, INC / 256, X.G, (int)blockIdx.x); S.Bt = (const char*)(ws + WS_WIN) + (size_t)L * INC * D * 2; S.K = D;
            EpiInProj E{QKV, (const f32x2*)(ws + WS_TABR), (const f32x2*)(ws + WS_TABC)};
            { const int co = L == 0 ? 0 : C_KA;
              thin_gemm(X, H + (size_t)NLAT * D, (const bf16_t*)(ws + WS_WIN) + (size_t)L * INC * D + (size_t)co * D, L == 0 ? INC : C_XIN - C_KA, D, ThinInProj{QKV, co}, X.vcu, X.G); }
            for (int rep = 0; rep < REPS(2); ++rep) { pg8::gemm_phase<EpiInProj, SchedPlain, true>(X.lds, (const char*)H, D, S, E); if (rep + 1 < REPS(2)) GRID_BAR(); }
            if (LBOTH(1)) GRID_BAR();
        }
        if (LIN(2)) {
            for (int rep = 0; rep < REPS(3); ++rep) {
            const float lam = ((const float*)(ws + WS_LAM))[L]; const float oscale = L == 0 ? 0.8f : (1.f - (0.8f - 0.6f * 0.74081822068171786607f));
            const float* gain = P.diff_subln + L * 128;
            for (int u = X.vcu; u < 512; u += X.G) { const int bh = (u & 255) >> 5, qblk = (u & 31) + 32 * (u >> 8); att::diff_unit_fast<false>(X, QKV, CAT, bh >> 2, bh & 3, qblk, lam, gain, oscale); }
            { const int n_na = 256, n_cd = L == 0 ? 16 : 0, n_cn = L == 0 ? 8 : 0, crows = L == 0 ? MROWS : NLAT, n_cv = (crows + 255) / 256, nq = n_na + n_cd + n_cn + n_cv;
              for (;;) {
                if (X.tid == 0) X.MISC[48] = __hip_atomic_fetch_add((unsigned*)(X.ctl + CW_MIXQ + 64 * L), 1u, RLX_AGENT);
                __syncthreads();
                int u = __builtin_amdgcn_readfirstlane((int)X.MISC[48]);
                __syncthreads();
                if (u >= nq) break;
                if (u < n_na) { const int b = u >> 7, h = (u >> 5) & 3, r0 = (u & 31) * 4; att::na_unit<false>(X, QKV, CAT, P.na_rpb + (L * 4 + h) * 465, b, h, r0); continue; } u -= n_na;
                if (L == 0 && u < n_cd) { att::diff_unit_fast<true>(X, QKV, CAT, u >> 3, (u >> 1) & 3, u & 1, lam, gain, oscale); continue; } u -= n_cd;
                if (L == 0 && u < n_cn) { att::na_unit<true>(X, QKV, CAT, nullptr, u >> 2, u & 3, 0); continue; } u -= n_cn;
                { const int r1 = u * 256 + 256; conv_rows(X, QKV, CAT, P.conv_w + L * 768, u * 256, r1 < crows ? r1 : crows); }
              } }
            if (rep + 1 < REPS(3)) GRID_BAR(); }
            if (LBOTH(2)) GRID_BAR();
        }
        if (LIN(3)) {
            SchedPlain S; S.T.init(NLAT / 256, D / 256, X.G, (int)blockIdx.x); S.Bt = (const char*)(ws + WS_WOUT) + (size_t)L * D * D * 2; S.K = D;
            EpiResGate E{xl, xc, P.out, XCTX, modp(X, L, 0, 2)};
            if (L == 0) thin_gemm(X, CAT + (size_t)NLAT * D, (const bf16_t*)(ws + WS_WOUT), D, D, ThinResGate{P.ctx, XCTX, modp(X, 0, 2, 2)}, X.vcu, X.G);
            pg8::gemm_phase<EpiResGate, SchedPlain, true>(X.lds, (const char*)CAT, D, S, E);
            if (LBOTH(3)) GRID_BAR();
        }
        if (L == 0) {
            if (IN(5)) { norm_phase(X, P.out, XCTX, modp(X, 0, 0, 3), modp(X, 0, 0, 4), H, MROWS); if (BOTH(5)) GRID_BAR(); }
            if (IN(6)) {
                SchedPlain S; S.T.init(NLAT / 256, 2 * DFF / 256, X.G, (int)blockIdx.x); S.Bt = (const char*)(ws + WS_W13); S.K = D;
                EpiSwiGLU E{HID, DFF};
                for (int rep = 0; rep < REPS(6); ++rep) { pg8::gemm_phase<EpiSwiGLU, SchedPlain, true>(X.lds, (const char*)H, D, S, E); if (rep + 1 < REPS(6)) GRID_BAR(); }
                { const int nun = (NLAT / 256) * (2 * DFF / 256), nshort = X.G - nun % X.G, b0 = (int)blockIdx.x - nun % X.G;
                  if (nun % X.G == 0) thin_gemm(X, H + (size_t)NLAT * D, (const bf16_t*)(ws + WS_W13), 2 * DFF, D, ThinSwiGLU{HID + (size_t)NLAT * DFF, DFF}, X.vcu, X.G);
                  else if (b0 >= 0) thin_gemm(X, H + (size_t)NLAT * D, (const bf16_t*)(ws + WS_W13), 2 * DFF, D, ThinSwiGLU{HID + (size_t)NLAT * DFF, DFF}, b0, nshort); }
                if (BOTH(6)) GRID_BAR();
            }
            if (IN(7)) {
                SchedPlain S; S.T.init(NLAT / 256, D / 256, X.G, (int)blockIdx.x); S.Bt = (const char*)(ws + WS_W2); S.K = DFF;
                EpiResGate E{P.out, XCTX, P.out, XCTX, modp(X, 0, 0, 5)};
                thin_gemm(X, HID + (size_t)NLAT * DFF, (const bf16_t*)(ws + WS_W2), D, DFF, ThinResGate{XCTX, XCTX, modp(X, 0, 2, 5)}, X.vcu, X.G);
                pg8::gemm_phase<EpiResGate, SchedPlain, true>(X.lds, (const char*)HID, DFF, S, E);
                if (BOTH(7)) GRID_BAR();
            }
        }
    }
    if (IN(12)) { moe_route_phase(X, P.out, modp(X, 1, 0, 3), modp(X, 1, 0, 4), P.router_w, (unsigned char*)H); if (BOTH(12)) GRID_BAR(); }
    if (IN(13)) {
        const int NP = moe_setup(X);
        SchedMoe<true> S; S.T.init(NP, 2 * DEXP / 256, X.G, (int)blockIdx.x); S.Bt = (const char*)(ws + WS_MW13); S.K = D / 2; S.estride = (size_t)2 * DEXP * D; S.M = X.MISC; S.tokl = (const int*)(ws + WS_TOKL);
        EpiSwiGLU8 E{ws + WS_MHID, DEXP};
        for (int rep = 0; rep < REPS(13); ++rep) { pg8::gemm_phase<EpiSwiGLU8, SchedMoe<true>, true, true>(X.lds, (const char*)H, D / 2, S, E); if (rep + 1 < REPS(13)) GRID_BAR(); }
        if (BOTH(13)) GRID_BAR();
    }
    if (IN(14)) {
        const int NP = moe_setup(X);
        SchedMoe<false> S; S.T.init(NP < 128 ? NP : 128, D / 256, X.G, (int)blockIdx.x); S.Bt = (const char*)(ws + WS_MW2); S.K = DEXP / 2; S.estride = (size_t)D * DEXP; S.M = X.MISC; S.tokl = nullptr;
        EpiStoreBf16 E{(bf16_t*)(ws + WS_Y), 1.f / MOE_W2_SCALE};
        for (int rep = 0; rep < REPS(14); ++rep) { pg8::gemm_phase<EpiStoreBf16, SchedMoe<false>, true, true>(X.lds, (const char*)(ws + WS_MHID), DEXP / 2, S, E); if (rep + 1 < REPS(14)) GRID_BAR(); }
        if (NP > 128) {
            SchedMoeTail St; St.first = (int)blockIdx.x; St.count = (NP - 128) * 4 * 7; St.Bt = (const char*)(ws + WS_MW2); St.K = DEXP / 2; St.estride = (size_t)D * DEXP; St.M = X.MISC;
            EpiTailPart Et{(bf16_t*)(ws + WS_YT), 1.f / MOE_W2_SCALE};
            pg8::gemm_phase<EpiTailPart, SchedMoeTail, true, true>(X.lds, (const char*)(ws + WS_MHID), DEXP / 2, St, Et, 256);
        }
        if (BOTH(14)) GRID_BAR();
    }
    if (IN(15)) { (void)moe_setup(X); final_phase(X, P.out, (const bf16_t*)(ws + WS_Y), modp(X, 1, 0, 5), P.final_gain); }
#undef IN
#undef LIN
#undef LBOTH
#undef BOTH
#undef GRID_BAR
}

extern "C" void kernel_launch(void* const* d_in, const int* in_sizes, int n_in, void* d_out, int out_size, void* d_ws, size_t ws_size, hipStream_t stream) {
    static int grid = 0;
    if (grid == 0) {
        if (n_in != 20 || in_sizes[0] != NLAT * D || out_size != NLAT * D || ws_size < WS_END) { fprintf(stderr, "kernel_launch: unexpected shapes (n_in %d, in0 %d, out %d, ws %zu < %zu)\n", n_in, n_in > 0 ? in_sizes[0] : -1, out_size, ws_size, (size_t)WS_END); grid = -1; return; }
        int dev = 0, cus = 0, per_cu = 0;
        if (hipGetDevice(&dev) != hipSuccess || hipDeviceGetAttribute(&cus, hipDeviceAttributeMultiprocessorCount, dev) != hipSuccess) { grid = -1; return; }
        if (hipFuncSetAttribute((const void*)fwd, hipFuncAttributeMaxDynamicSharedMemorySize, LDS_BYTES) != hipSuccess) { fprintf(stderr, "kernel_launch: hipFuncSetAttribute failed\n"); grid = -1; return; }
        if (hipOccupancyMaxActiveBlocksPerMultiprocessor(&per_cu, (const void*)fwd, NWAVES * 64, LDS_BYTES) != hipSuccess || per_cu < 1) { fprintf(stderr, "kernel_launch: occupancy query says %d blocks per CU\n", per_cu); }
        (void)hipGetLastError();
        grid = cus;
    }
    if (grid < 0) return;
    if (hipMemsetAsync((char*)d_ws + WS_CTL, 0, CTL_ZERO_BYTES, stream) != hipSuccess) return;
    Params p{};
    const float** pp = (const float**)&p;
    for (int i = 0; i < 20; ++i) pp[i] = (const float*)d_in[i];
    p.out = (float*)d_out; p.ws = (unsigned char*)d_ws;
    for (int li = 0; li < N_LAUNCHES; ++li) {
        p.ph_lo = (N_LAUNCHES == N_PHASES) ? li : 0; p.ph_hi = (N_LAUNCHES == N_PHASES) ? li + 1 : N_PHASES; p.li = li; p.pad = 0;
        hipLaunchKernelGGL(fwd, dim3(grid), dim3(NWAVES * 64), LDS_BYTES, stream, p);
    }
}
```

```cpp
#include <hip/hip_runtime.h>
#include <cstdio>
#include <cstdint>

#define LAS __attribute__((address_space(3)))
#define GAS __attribute__((address_space(1)))
typedef unsigned short bf16_t;
typedef short bf16x8 __attribute__((ext_vector_type(8)));
typedef short s16x4 __attribute__((ext_vector_type(4)));
typedef float f32x2 __attribute__((ext_vector_type(2)));
typedef float f32x4 __attribute__((ext_vector_type(4)));
typedef float f32x16 __attribute__((ext_vector_type(16)));
typedef unsigned u32x2 __attribute__((ext_vector_type(2)));
typedef unsigned u32x4 __attribute__((ext_vector_type(4)));
typedef GAS unsigned gu32;
typedef __bf16 bf16x2_t __attribute__((ext_vector_type(2)));

#ifndef MK_N_LAUNCHES
#define MK_N_LAUNCHES 1
#endif

constexpr int D = 1024, BATCH = 2, SEQ = 8192, NLAT = BATCH * SEQ, CTXL = 256, NCTX = BATCH * CTXL, MROWS = NLAT + NCTX;
constexpr int GRIDW = 64, GROWS = SEQ / GRIDW;
constexpr int INC = 3072, DFF = 2816, DEXP = 3584, NEXP = 8;
constexpr int KVR = CTXL + SEQ;
constexpr int QKVROWS = BATCH * KVR;
constexpr int C_QA = 0, C_QB = 256, C_KA = 768, C_KB = 1024, C_VA = 1536, C_VB = 1792, C_XIN = 2304, C_BG = 2560, C_CG = 2816;
constexpr float EPS = 1e-6f;
constexpr float LOG2E = 1.4426950408889634f;
constexpr float C2 = 0.125f * LOG2E;
constexpr int MOE_MAXP = 136;

constexpr size_t MiB = 1u << 20;
constexpr size_t WS_CTL = 0, CTL_ZERO_BYTES = 1 * MiB;
constexpr size_t WS_MODS = 1 * MiB;
constexpr size_t WS_TABR = WS_MODS + 2 * 3 * 6144 * 4;
constexpr size_t WS_TABC = WS_TABR + 128 * 16 * 8;
constexpr size_t WS_LAM = WS_TABC + 64 * 16 * 8;
constexpr size_t WS_TOKL = 2 * MiB;
constexpr size_t WS_GATL = WS_TOKL + 8 * 16384 * 4;
constexpr size_t WS_TINFO = 3 * MiB;
constexpr size_t WS_XCTX = 4 * MiB;
constexpr size_t WS_MW2 = 6 * MiB;
constexpr size_t WS_MW13 = 62 * MiB;
constexpr size_t WS_H = 174 * MiB;
constexpr size_t WS_Y = 62 * MiB;
constexpr size_t WS_ARENA = 207 * MiB;
constexpr size_t WS_WIN = WS_ARENA;
constexpr size_t WS_WOUT = WS_WIN + 12 * MiB;
constexpr size_t WS_W13 = WS_WOUT + 4 * MiB;
constexpr size_t WS_W2 = WS_W13 + 11 * MiB;
constexpr size_t WS_QKV = WS_W2 + 6 * MiB;
constexpr size_t WS_CAT = WS_QKV + 99 * MiB;
constexpr size_t WS_HID = WS_CAT + 33 * MiB;
constexpr size_t WS_MHID = WS_ARENA;
constexpr size_t WS_YT = WS_ARENA + 238 * MiB;
constexpr size_t WS_END = WS_YT + 28 * MiB;
static_assert(WS_YT >= WS_MHID + (size_t)MOE_MAXP * 256 * DEXP * 2, "tail partials behind the MoE hidden buffer");
static_assert(WS_Y + (size_t)MOE_MAXP * 256 * D * 4 <= WS_ARENA, "Y overlay");
static_assert(WS_MHID + (size_t)MOE_MAXP * 256 * DEXP * 2 <= WS_END, "MoE hidden overlay");
static_assert(WS_TINFO + (size_t)NLAT * 32 <= WS_XCTX && WS_LAM + 64 <= WS_TOKL, "map");
constexpr int CW_TMO = 0, CW_CODE = 1, CW_BAR = 4096, CW_ECNT = 16384, CW_MOEQ = 24576;

constexpr int RING_BYTES = 131072;
constexpr int MISC_OFF = RING_BYTES + 320;
constexpr int LDS_BYTES = 147456;
constexpr int NWAVES = 8;

__device__ __forceinline__ unsigned cvt_pk_bf16(float lo, float hi) { unsigned r; asm volatile("v_cvt_pk_bf16_f32 %0, %1, %2" : "=v"(r) : "v"(lo), "v"(hi)); return r; }
__device__ __forceinline__ unsigned pk_fp8x4(float a, float b, float c, float d) { int w = 0; w = __builtin_amdgcn_cvt_pk_fp8_f32(a, b, w, false); w = __builtin_amdgcn_cvt_pk_fp8_f32(c, d, w, true); return (unsigned)w; }
constexpr float MOE_W13_SCALE = 32.f, MOE_W2_SCALE = 64.f;
__device__ __forceinline__ float bf2f(unsigned short b) { return __builtin_bit_cast(float, (unsigned)b << 16); }
template <int CTRL> __device__ __forceinline__ float dpp_xadd(float v) { return v + __int_as_float(__builtin_amdgcn_update_dpp(__float_as_int(v), __float_as_int(v), CTRL, 0xF, 0xF, false)); }
__device__ __forceinline__ float wave_sum(float v) {
    v = dpp_xadd<0xB1>(v);
    v = dpp_xadd<0x4E>(v);
    v = dpp_xadd<0x141>(v);
    v = dpp_xadd<0x140>(v);
    const int vi = __float_as_int(v);
    const float r0 = __int_as_float(__builtin_amdgcn_readlane(vi, 0)), r1 = __int_as_float(__builtin_amdgcn_readlane(vi, 16)), r2 = __int_as_float(__builtin_amdgcn_readlane(vi, 32)), r3 = __int_as_float(__builtin_amdgcn_readlane(vi, 48));
    return (r0 + r1) + (r2 + r3);
}
__device__ __forceinline__ int fresh_tid() { int t = threadIdx.x; asm volatile("" : "+v"(t)); return t; }
__device__ __forceinline__ void st16_wt(void* p, u32x4 v) { asm volatile("global_store_dwordx4 %0, %1, off sc0 sc1\n\ts_nop 1" :: "v"(p), "v"(v) : "memory"); }
__device__ __forceinline__ void st8_wt(void* p, u32x2 v) { asm volatile("global_store_dwordx2 %0, %1, off sc0 sc1\n\ts_nop 1" :: "v"(p), "v"(v) : "memory"); }
#define LDS_WAIT() asm volatile("s_waitcnt lgkmcnt(0)" ::: "memory")
#define VM_WAIT() asm volatile("s_waitcnt vmcnt(0)" ::: "memory")
#define RLX_AGENT __ATOMIC_RELAXED, __HIP_MEMORY_SCOPE_AGENT

namespace pg8 {
constexpr int BM = 256, BK = 64, HALF = 128, HTB = HALF * BK * 2, STAGE_BYTES = 8 * HTB, NXCD = 8, WGM = 8;
__host__ __device__ __forceinline__ int lds_byte(int r, int c) { const int st = (r >> 4) * 2 + (c >> 5), rr = r & 15, cc = c & 31, ob = rr * 64 + cc * 2; return st * 1024 + (ob ^ (((ob >> 9) & 1) << 5)); }
__host__ __device__ __forceinline__ void stage_rc(int b, int& R, int& C) { const int st = b / 1024, sb = b % 1024, swz = sb ^ (((sb >> 9) & 1) << 5); R = (st >> 1) * 16 + swz / 64; C = (st & 1) * 32 + (swz % 64) / 2; }
__host__ __device__ __forceinline__ int perm32(int rho) { const int n = rho >> 4, i = rho & 15; return 8 * (i >> 2) + 4 * n + (i & 3); }

struct Unit { int pm, pn, e, pl; };

struct TileOrder {
    int nM, nN, nwg, G, c;
    __device__ __forceinline__ void init(int nM_, int nN_, int G_, int c_) { nM = nM_; nN = nN_; nwg = nM * nN; G = G_; c = c_; }
    __device__ __forceinline__ bool tile(int i, int& pm, int& pn) const { return tileL((long)i * G + c, pm, pn); }
    __device__ __forceinline__ bool tileL(long L, int& pm, int& pn) const {
        if (L >= nwg) return false;
        int wgid = (int)L; { const int q = nwg / NXCD, r = nwg % NXCD, xcd = wgid % NXCD, off = wgid / NXCD; wgid = (xcd < r ? xcd * (q + 1) : r * (q + 1) + (xcd - r) * q) + off; }
        const int nig = WGM * nN, gid = wgid / nig, fm = gid * WGM, gsz = (nM - fm) < WGM ? (nM - fm) : WGM;
        pm = fm + ((wgid % nig) % gsz); pn = (wgid % nig) / gsz; return true;
    }
};

template <class Epi, class Sched, bool ALIGN_EPI, bool F8 = false>
__device__ __forceinline__ void gemm_phase(LAS unsigned char* lds, const char* Abase, const int K, const Sched& S, const Epi& E, const int Klen = 0) {
    const int tid = fresh_tid(), wid = __builtin_amdgcn_readfirstlane(tid >> 6), lane = tid & 63, wr = wid >> 2, wc = wid & 3, fr = lane & 15, fq = lane >> 4;
    const int nt = (Klen ? Klen : K) / BK;
    int Rr[2], Cc[2]; unsigned voffB[2];
#pragma unroll
    for (int i = 0; i < 2; ++i) { int R, C; stage_rc(tid * 16 + i * 8192, R, C); const int Rb = Epi::PERM ? ((R & ~31) + perm32(R & 31)) : R; Rr[i] = R; Cc[i] = C; voffB[i] = (unsigned)(Rb * K + C) * 2u; }
    const size_t kstep = (size_t)(BK * 2);
    const size_t hstep = (size_t)HALF * K * 2;
    const unsigned ldsw = (unsigned)wid * 1024u;
    const int aoff = lds_byte(wr * 64 + fr, fq * 8), boff = lds_byte(wc * 32 + fr, fq * 8);
#define PG8_SA(b, h) (((b) * 2 + (h)) * HTB)
#define PG8_SB(b, h) ((4 + (b) * 2 + (h)) * HTB)
#define PG8_STAGE(bufoff, gbase, voff) do { _Pragma("unroll") for (int _i = 0; _i < 2; ++_i) \
        __builtin_amdgcn_global_load_lds((const unsigned*)((const char*)(gbase) + (voff)[_i]), (LAS unsigned*)(lds + (bufoff) + ldsw + _i * 8192), 16, 0, 0); } while (0)
    typedef int v4i_ __attribute__((ext_vector_type(4))); typedef int v8i_ __attribute__((ext_vector_type(8)));
#define PG8_LDA(dst, b, h) do { _Pragma("unroll") for (int m = 0; m < 4; ++m) { if constexpr (F8) { dst##8[m] = __builtin_shufflevector(*(const LAS v4i_*)(lds + PG8_SA(b, h) + aoff + m * 2048), *(const LAS v4i_*)(lds + PG8_SA(b, h) + aoff + m * 2048 + 1024), 0, 1, 2, 3, 4, 5, 6, 7); } \
        else { _Pragma("unroll") for (int k = 0; k < 2; ++k) dst[m][k] = *(const LAS bf16x8*)(lds + PG8_SA(b, h) + aoff + m * 2048 + k * 1024); } } } while (0)
#define PG8_LDB(dst, b, h) do { _Pragma("unroll") for (int n = 0; n < 2; ++n) { if constexpr (F8) { dst##8[n] = __builtin_shufflevector(*(const LAS v4i_*)(lds + PG8_SB(b, h) + boff + n * 2048), *(const LAS v4i_*)(lds + PG8_SB(b, h) + boff + n * 2048 + 1024), 0, 1, 2, 3, 4, 5, 6, 7); } \
        else { _Pragma("unroll") for (int k = 0; k < 2; ++k) dst[n][k] = *(const LAS bf16x8*)(lds + PG8_SB(b, h) + boff + n * 2048 + k * 1024); } } } while (0)
#define PG8_MMA(ai, bj, At, Bt) do { __builtin_amdgcn_s_setprio(1); _Pragma("unroll") for (int m = 0; m < 4; ++m) _Pragma("unroll") for (int n = 0; n < 2; ++n) { \
          \
        if constexpr (F8) asm("v_mfma_f32_16x16x128_f8f6f4 %0, %1, %2, %0" : "+v"(acc[ai][bj][m][n]) : "v"(Bt##8[n]), "v"(At##8[m]));   \
        else { _Pragma("unroll") for (int k = 0; k < 2; ++k) acc[ai][bj][m][n] = __builtin_amdgcn_mfma_f32_16x16x32_bf16(Bt[n][k], At[m][k], acc[ai][bj][m][n], 0, 0, 0); } } \
        __builtin_amdgcn_s_setprio(0); } while (0)
#define PG8_WAIT_V(n) asm volatile("s_waitcnt vmcnt(" #n ")" ::: "memory")
#define PG8_WAIT_L(n) asm volatile("s_waitcnt lgkmcnt(" #n ")" ::: "memory")
#define PG8_BAR __builtin_amdgcn_s_barrier()
#define PG8_SCHED __builtin_amdgcn_sched_barrier(0)
    Unit cur, nxt; int ui = 0;
    if (!S.next(0, cur)) return;
    f32x4 acc[2][2][4][2];
#pragma unroll
    for (int a = 0; a < 2; ++a)
#pragma unroll
        for (int b = 0; b < 2; ++b)
#pragma unroll
            for (int m = 0; m < 4; ++m)
#pragma unroll
                for (int n = 0; n < 2; ++n) acc[a][b][m][n] = (f32x4){0.f, 0.f, 0.f, 0.f};
    bf16x8 At[4][2], B0[2][2], B1[2][2]; v8i_ At8[4], B08[2], B18[2];
    constexpr bool GATHER = Sched::GATHER;
    unsigned voffA[2]; unsigned cv[2][2], nv[2][2];
#pragma unroll
    for (int i = 0; i < 2; ++i) voffA[i] = (unsigned)(Rr[i] * K + Cc[i]) * 2u;
    const char* cA = Abase; const char* nA = Abase;
    if constexpr (GATHER) S.a_offs(cur, Rr, Cc, cv); else cA = Abase + S.a_tile(cur);
    const char* cB = S.b_tile(cur);
#define PG8_STAGE_A(bufoff, h, kb, NX) do { if constexpr (GATHER) { const unsigned _v[2] = {(NX) ? nv[h][0] : cv[h][0], (NX) ? nv[h][1] : cv[h][1]}; PG8_STAGE(bufoff, Abase + (kb), _v); } \
        else { PG8_STAGE(bufoff, ((NX) ? nA : cA) + (h) * hstep + (kb), voffA); } } while (0)
    PG8_STAGE(PG8_SB(0, 0), cB, voffB); PG8_STAGE(PG8_SB(0, 1), cB + hstep, voffB); PG8_STAGE_A(PG8_SA(0, 0), 0, 0, false); PG8_STAGE_A(PG8_SA(0, 1), 1, 0, false);
    if (wr == 1) PG8_BAR;
    PG8_WAIT_V(2); PG8_BAR;
    PG8_STAGE(PG8_SB(1, 0), cB + kstep, voffB); PG8_STAGE_A(PG8_SA(1, 0), 0, kstep, false); PG8_STAGE(PG8_SB(1, 1), cB + hstep + kstep, voffB);
    PG8_WAIT_V(6); PG8_BAR;
    for (;;) {
        const bool has_next = S.next(ui + 1, nxt);
        const char* nB = cB; nA = cA;
        if (has_next) { if constexpr (GATHER) S.a_offs(nxt, Rr, Cc, nv); else nA = Abase + S.a_tile(nxt); nB = S.b_tile(nxt); }
        else { if constexpr (GATHER) {
#pragma unroll
            for (int h = 0; h < 2; ++h)
#pragma unroll
                for (int i = 0; i < 2; ++i) nv[h][i] = cv[h][i]; } }
#pragma unroll 1
        for (int t = 0; t < nt; t += 2) {
            const bool last = (t == nt - 2);
            const size_t k1 = (size_t)(t + 1) * kstep, k2 = last ? (size_t)0 : (size_t)(t + 2) * kstep, k3 = k2 + kstep;
            const char* b2 = last ? nB : cB + (size_t)(t + 2) * kstep; const char* b3 = b2 + kstep;
            PG8_LDB(B0, 0, 0); PG8_LDB(B1, 0, 1); PG8_SCHED; PG8_LDA(At, 0, 0); PG8_STAGE_A(PG8_SA(1, 1), 1, k1, false);
            PG8_WAIT_V(8); PG8_WAIT_L(0); PG8_BAR; PG8_MMA(0, 0, At, B0); PG8_MMA(0, 1, At, B1); PG8_BAR; PG8_SCHED;
            PG8_LDA(At, 0, 1); PG8_STAGE(PG8_SB(0, 0), b2, voffB); PG8_STAGE(PG8_SB(0, 1), b2 + hstep, voffB); PG8_STAGE_A(PG8_SA(0, 0), 0, k2, last);
            PG8_WAIT_V(8); PG8_WAIT_L(0); PG8_BAR; PG8_MMA(1, 0, At, B0); PG8_MMA(1, 1, At, B1); PG8_BAR; PG8_SCHED;
            PG8_LDB(B0, 1, 0); PG8_LDB(B1, 1, 1); PG8_SCHED; PG8_LDA(At, 1, 0); PG8_STAGE_A(PG8_SA(0, 1), 1, k2, last);
            PG8_WAIT_V(8); PG8_WAIT_L(0); PG8_BAR; PG8_MMA(0, 0, At, B0); PG8_MMA(0, 1, At, B1); PG8_BAR; PG8_SCHED;
            PG8_LDA(At, 1, 1); PG8_STAGE(PG8_SB(1, 0), b3, voffB); PG8_STAGE(PG8_SB(1, 1), b3 + hstep, voffB); PG8_STAGE_A(PG8_SA(1, 0), 0, k3, last);
            PG8_WAIT_V(8); PG8_WAIT_L(0); PG8_BAR; PG8_MMA(1, 0, At, B0); PG8_MMA(1, 1, At, B1); PG8_BAR; PG8_SCHED;
        }
        if constexpr (ALIGN_EPI) { if (wr == 0) PG8_BAR; }
        if constexpr (F8) asm volatile("s_nop 15\n\ts_nop 15" ::: "memory");
        E(acc, cur, wr, wc, fr, fq);
        if (!has_next) break;
#pragma unroll
        for (int a = 0; a < 2; ++a)
#pragma unroll
            for (int b = 0; b < 2; ++b)
#pragma unroll
                for (int m = 0; m < 4; ++m)
#pragma unroll
                    for (int n = 0; n < 2; ++n) acc[a][b][m][n] = (f32x4){0.f, 0.f, 0.f, 0.f};
        cur = nxt; cB = nB; cA = nA; ++ui;
        if constexpr (GATHER) {
#pragma unroll
            for (int h = 0; h < 2; ++h)
#pragma unroll
                for (int i = 0; i < 2; ++i) cv[h][i] = nv[h][i]; }
        if constexpr (ALIGN_EPI) { if (wr == 1) PG8_BAR; }
    }
    PG8_WAIT_V(0);
    if constexpr (!ALIGN_EPI) { if (wr == 0) PG8_BAR; }
    PG8_BAR;
#undef PG8_SA
#undef PG8_SB
#undef PG8_STAGE
#undef PG8_STAGE_A
#undef PG8_LDA
#undef PG8_LDB
#undef PG8_MMA
#undef PG8_WAIT_V
#undef PG8_WAIT_L
#undef PG8_BAR
#undef PG8_SCHED
}
}

#define XB_TMO      128
#define XB_XCNT(j)  (256  + 64 * (j))
#define XB_XSUB(j)  (1280 + 64 * (j))
#define XB_XGEN(j)  (2304 + 64 * (j))
#define XB_TOP      3328
#define XB_TOPGEN   3392
#define XCD_BAR_WORDS 3456
#define XB_SPIN_CAP (1u << 18)
__device__ __forceinline__ unsigned xb_ld(unsigned* p)              { return __hip_atomic_load(p, __ATOMIC_RELAXED, __HIP_MEMORY_SCOPE_AGENT); }
__device__ __forceinline__ unsigned xb_add(unsigned* p, unsigned v) { return __hip_atomic_fetch_add(p, v, __ATOMIC_RELAXED, __HIP_MEMORY_SCOPE_AGENT); }
__device__ __forceinline__ unsigned xb_xcc_id() { return (unsigned)__builtin_amdgcn_s_getreg((3 << 11) | 20) & 0xFu; }
#define XB_SPIN(cond, bar) do { unsigned _sp = 0; while (cond) { __builtin_amdgcn_s_sleep(1); \
    if ((++_sp & 255u) == 0u) { if (xb_ld(&(bar)[XB_TMO])) break; if (_sp > XB_SPIN_CAP) { atomicAdd(&(bar)[XB_TMO], 1u); break; } } } } while (0)
struct XcdBarrier { unsigned* bar; unsigned x; volatile LAS unsigned* st; };
__device__ __forceinline__ XcdBarrier xcd_barrier_post(unsigned* bar, volatile LAS unsigned* st) {
    XcdBarrier b; b.bar = bar; b.x = xb_xcc_id(); b.st = st;
    if (threadIdx.x == 0) (void)xb_add(&bar[XB_XCNT(b.x)], 1u);
    return b;
}
__device__ __forceinline__ void xcd_barrier_complete(unsigned* bar, unsigned x, unsigned& nloc, unsigned& nx) {
    const unsigned G = gridDim.x * gridDim.y * gridDim.z;
    unsigned sum, cnt, mine, sp = 0u;
    for (;;) {
        sum = 0u; cnt = 0u; mine = 0u;
#pragma unroll
        for (unsigned j = 0; j < 16; ++j) { const unsigned c = xb_ld(&bar[XB_XCNT(j)]); sum += c; cnt += (c > 0u) ? 1u : 0u; mine = (j == x) ? c : mine; }
        if (sum == G) break;
        __builtin_amdgcn_s_sleep(1);
        if ((++sp & 255u) == 0u) { if (xb_ld(&bar[XB_TMO])) break; if (sp > XB_SPIN_CAP) { atomicAdd(&bar[XB_TMO], 1u); break; } }
    }
    nloc = mine > 0u ? mine : 1u; nx = cnt > 0u ? cnt : 1u;
}
__device__ __forceinline__ void xcd_barrier(const XcdBarrier& b) {
    asm volatile("s_waitcnt vmcnt(0)" ::: "memory");
    __syncthreads();
    if (threadIdx.x == 0) {
        unsigned* bar = b.bar;
        __builtin_amdgcn_s_waitcnt(0);
        unsigned nloc = b.st[0], nx = b.st[1];
        if (nloc == 0u) { xcd_barrier_complete(bar, b.x, nloc, nx); b.st[0] = nloc; b.st[1] = nx; }
        const unsigned old = xb_add(&bar[XB_XSUB(b.x)], 1u);
        const unsigned gen = old / nloc;
        if (old + 1u == (gen + 1u) * nloc) {
            __builtin_amdgcn_fence(__ATOMIC_RELEASE, "agent");
            asm volatile("s_waitcnt vmcnt(0)" ::: "memory");
            const unsigned og = xb_add(&bar[XB_TOP], 1u);
            const unsigned tg = og / nx;
            if (og + 1u == (tg + 1u) * nx) xb_add(&bar[XB_TOPGEN], 1u);
            else XB_SPIN(xb_ld(&bar[XB_TOPGEN]) == tg, bar);
            __builtin_amdgcn_fence(__ATOMIC_ACQUIRE, "agent");
            xb_add(&bar[XB_XGEN(b.x)], 1u);
            asm volatile("s_waitcnt vmcnt(0)" ::: "memory");
        } else {
            XB_SPIN(xb_ld(&bar[XB_XGEN(b.x)]) == gen, bar);
            __builtin_amdgcn_fence(__ATOMIC_ACQUIRE, "agent");
            asm volatile("s_waitcnt vmcnt(0)" ::: "memory");
        }
    }
    __syncthreads();
}

struct Params {
    const float *x, *c, *ctx, *c_ctx, *ada_w, *ada_b, *w_in, *w_out, *na_rpb, *diff_lambda, *diff_subln, *conv_w,
                *ffn_w1, *ffn_w3, *ffn_w2, *router_w, *moe_w1, *moe_w3, *moe_w2, *final_gain;
    float* out; unsigned char* ws;
    int ph_lo, ph_hi, li, pad;
};
struct Ctx {
    LAS unsigned char* lds; char* ldsg;
    volatile LAS unsigned* MISC;
    gu32* ctl;
    int tid, lane, wave, vcu, G;
    unsigned char* ws;
};
__device__ __forceinline__ Ctx fresh(const Ctx& X0) { Ctx X = X0; X.tid = fresh_tid(); X.lane = X.tid & 63; X.wave = __builtin_amdgcn_readfirstlane(X.tid >> 6); return X; }
__device__ __forceinline__ const float* modp(const Ctx& X, int layer, int v, int idx) { return (const float*)(X.ws + WS_MODS) + ((size_t)(layer * 3 + v) * 6 + idx) * D; }

struct SchedPlain {
    static constexpr bool GATHER = false;
    pg8::TileOrder T; const char* Bt; int K;
    __device__ __forceinline__ bool next(int i, pg8::Unit& u) const { u.e = 0; const bool ok = T.tile(i, u.pm, u.pn); u.pl = u.pm; return ok; }
    __device__ __forceinline__ size_t a_tile(const pg8::Unit& u) const { return (size_t)u.pm * 256 * K * 2; }
    __device__ __forceinline__ void a_offs(const pg8::Unit&, const int (&)[2], const int (&)[2], unsigned (&)[2][2]) const {}
    __device__ __forceinline__ const char* b_tile(const pg8::Unit& u) const { return Bt + (size_t)u.pn * 256 * K * 2; }
};
template <bool GATHER_> struct SchedMoe {
    static constexpr bool GATHER = GATHER_;
    pg8::TileOrder T; const char* Bt; int K; size_t estride; volatile LAS unsigned* M; const int* tokl;
    gu32* q; int Rs;
    __device__ __forceinline__ int qtotal(int j) const { const int t = (T.nwg - Rs * T.G - j + 7) >> 3; return t > 0 ? t : 0; }
    __device__ __forceinline__ bool next(int i, pg8::Unit& u) const {
        long L = (long)i * T.G + T.c;
        if (i >= Rs) {
            if (threadIdx.x == 0) {
                const int x = T.c & 7, base = Rs * T.G; int res = -1;
                if (M[51] == 0u) { const int r = (int)__hip_atomic_fetch_add((unsigned*)(q + 64 * x), 1u, RLX_AGENT); if (r < qtotal(x)) res = base + 8 * r + x; else M[51] = 1u; }
                for (int tries = 0; res < 0 && tries < 16; ++tries) {
                    int best = -1, brem = 0;
#pragma unroll
                    for (int j = 0; j < 8; ++j) { const int rem = qtotal(j) - (int)__hip_atomic_load((unsigned*)(q + 64 * j), RLX_AGENT); if (rem > brem) { brem = rem; best = j; } }
                    if (best < 0) break;
                    const int r = (int)__hip_atomic_fetch_add((unsigned*)(q + 64 * best), 1u, RLX_AGENT); if (r < qtotal(best)) res = base + 8 * r + best;
                }
                M[50] = (unsigned)res;
            }
            asm volatile("s_waitcnt lgkmcnt(0)" ::: "memory"); __builtin_amdgcn_s_barrier(); asm volatile("" ::: "memory");
            const int res = __builtin_amdgcn_readfirstlane((int)M[50]);
            if (res < 0) return false;
            L = res;
        }
        const bool ok = T.tileL(L, u.pm, u.pn); if (!ok) return false;
        int e = 0;
#pragma unroll
        for (int k = 1; k < NEXP; ++k) e += ((int)M[16 + k] <= u.pm) ? 1 : 0;
        u.e = __builtin_amdgcn_readfirstlane(e); u.pl = u.pm - (int)M[16 + u.e]; return true;
    }
    __device__ __forceinline__ size_t a_tile(const pg8::Unit& u) const { return (size_t)u.pm * 256 * K * 2; }
    __device__ __forceinline__ void a_offs(const pg8::Unit& u, const int (&R)[2], const int (&C)[2], unsigned (&v)[2][2]) const {
        const int cnt = (int)M[32 + u.e];
#pragma unroll
        for (int h = 0; h < 2; ++h)
#pragma unroll
            for (int i = 0; i < 2; ++i) { const int idx = u.pl * 256 + h * 128 + R[i]; const int tok = idx < cnt ? tokl[u.e * 16384 + idx] : 0; v[h][i] = (unsigned)(tok * K + C[i]) * 2u; }
    }
    __device__ __forceinline__ const char* b_tile(const pg8::Unit& u) const { return Bt + (size_t)u.e * estride + (size_t)u.pn * 256 * K * 2; }
};

struct EpiInProj {
    static constexpr bool PERM = true;
    bf16_t* QKV; const f32x2* tabR; const f32x2* tabC;
    __device__ __forceinline__ void operator()(const f32x4 (&acc)[2][2][4][2], const pg8::Unit& u, int wr, int wc, int fr, int fq) const {
        const int pm = u.pm, pn = u.pn; const bool isctx = pm >= 64;
        const int opanel = isctx ? (pm - 64) * 33 : (pm + 1 + (pm >= 32 ? 1 : 0));
        const int orow0 = opanel * 256 + wr * 64 + fr, arow0 = pm * 256 + wr * 64 + fr;
        const int col0 = pn * 256 + wc * 32 + 8 * fq;
        const bool rope = !isctx && (pn == 1 || pn == 2 || pn == 4 || pn == 5);
        const float sc = (pn <= 2) ? C2 : 1.f;
#pragma unroll
        for (int ai = 0; ai < 2; ++ai)
#pragma unroll
            for (int m = 0; m < 4; ++m) {
                const int t = (arow0 + ai * 128 + m * 16) & (SEQ - 1);
                f32x4 cs0 = (f32x4){1.f, 0.f, 1.f, 0.f}, cs1 = cs0;
                if (rope) { const f32x4* tb = (const f32x4*)(((wc & 1) ? tabC + (t & 63) * 16 : tabR + (t >> 6) * 16) + 4 * fq); cs0 = tb[0]; cs1 = tb[1]; }
                bf16_t* rowp = QKV + (size_t)(orow0 + ai * 128 + m * 16) * INC + col0;
#pragma unroll
                for (int bj = 0; bj < 2; ++bj) {
                    f32x4 v0 = acc[ai][bj][m][0], v1 = acc[ai][bj][m][1];
                    if (rope) {
                        const f32x4 c = (f32x4){cs0[0], cs0[2], cs1[0], cs1[2]}, s = (f32x4){cs0[1], cs0[3], cs1[1], cs1[3]};
                        const f32x4 o1 = v0 * c - v1 * s, o2 = v1 * c + v0 * s; v0 = o1; v1 = o2;
                    }
                    v0 = v0 * sc; v1 = v1 * sc;
                    u32x4 w; w.x = cvt_pk_bf16(v0[0], v0[1]); w.y = cvt_pk_bf16(v0[2], v0[3]); w.z = cvt_pk_bf16(v1[0], v1[1]); w.w = cvt_pk_bf16(v1[2], v1[3]);
                    *(u32x4*)(rowp + bj * 128) = w;
                }
            }
    }
};
struct EpiResGate {
    static constexpr bool PERM = false;
    const float* base_lat; const float* base_ctx; float* out_lat; float* out_ctx; const float* gate0;
    __device__ __forceinline__ void operator()(const f32x4 (&acc)[2][2][4][2], const pg8::Unit& u, int wr, int wc, int fr, int fq) const {
        const int pm = u.pm; const int v = pm < 32 ? 0 : (pm < 64 ? 1 : 2);
        const float* base = pm < 64 ? base_lat : base_ctx; float* out = pm < 64 ? out_lat : out_ctx;
        const int row0 = (pm < 64 ? pm : pm - 64) * 256 + wr * 64 + fr;
        const int col0 = u.pn * 256 + wc * 32 + 4 * fq;
        const float* g = gate0 + (size_t)v * 6 * D + col0;
        f32x4 gv[2][2];
#pragma unroll
        for (int bj = 0; bj < 2; ++bj)
#pragma unroll
            for (int n = 0; n < 2; ++n) gv[bj][n] = *(const f32x4*)(g + bj * 128 + n * 16);
#pragma unroll
        for (int ai = 0; ai < 2; ++ai)
#pragma unroll
            for (int m = 0; m < 4; ++m) { const size_t off = (size_t)(row0 + ai * 128 + m * 16) * D + col0;
#pragma unroll
                for (int bj = 0; bj < 2; ++bj)
#pragma unroll
                    for (int n = 0; n < 2; ++n) { const f32x4 bs = *(const f32x4*)(base + off + bj * 128 + n * 16); *(f32x4*)(out + off + bj * 128 + n * 16) = bs + gv[bj][n] * acc[ai][bj][m][n]; }
                if (m & 1) asm volatile("" ::: "memory"); }
    }
};
__device__ __forceinline__ float silu_f(float x) { return x * __builtin_amdgcn_rcpf(1.f + __builtin_amdgcn_exp2f(-x * LOG2E)); }
struct EpiSwiGLU {
    static constexpr bool PERM = true;
    bf16_t* H; int ldc;
    __device__ __forceinline__ void operator()(const f32x4 (&acc)[2][2][4][2], const pg8::Unit& u, int wr, int wc, int fr, int fq) const {
        const int row0 = u.pm * 256 + wr * 64 + fr, col0 = u.pn * 128 + wc * 32 + 8 * fq;
#pragma unroll
        for (int ai = 0; ai < 2; ++ai)
#pragma unroll
            for (int m = 0; m < 4; ++m) { bf16_t* rowp = H + (size_t)(row0 + ai * 128 + m * 16) * ldc + col0;
                u32x4 w;
                { const f32x4 a = acc[ai][0][m][0], b = acc[ai][0][m][1]; w.x = cvt_pk_bf16(silu_f(a[0]) * b[0], silu_f(a[1]) * b[1]); w.y = cvt_pk_bf16(silu_f(a[2]) * b[2], silu_f(a[3]) * b[3]); }
                { const f32x4 a = acc[ai][1][m][0], b = acc[ai][1][m][1]; w.z = cvt_pk_bf16(silu_f(a[0]) * b[0], silu_f(a[1]) * b[1]); w.w = cvt_pk_bf16(silu_f(a[2]) * b[2], silu_f(a[3]) * b[3]); }
                *(u32x4*)rowp = w; }
    }
};
struct EpiStoreBf16 {
    static constexpr bool PERM = true;
    bf16_t* Y; float scale;
    __device__ __forceinline__ void operator()(const f32x4 (&acc)[2][2][4][2], const pg8::Unit& u, int wr, int wc, int fr, int fq) const {
        const int row0 = u.pm * 256 + wr * 64 + fr, col0 = u.pn * 256 + wc * 32 + 8 * fq;
#pragma unroll
        for (int ai = 0; ai < 2; ++ai)
#pragma unroll
            for (int m = 0; m < 4; ++m) { bf16_t* rowp = Y + (size_t)(row0 + ai * 128 + m * 16) * D + col0;
#pragma unroll
                for (int bj = 0; bj < 2; ++bj) { const f32x4 v0 = acc[ai][bj][m][0] * scale, v1 = acc[ai][bj][m][1] * scale;
                    u32x4 w; w.x = cvt_pk_bf16(v0[0], v0[1]); w.y = cvt_pk_bf16(v0[2], v0[3]); w.z = cvt_pk_bf16(v1[0], v1[1]); w.w = cvt_pk_bf16(v1[2], v1[3]);
                    *(u32x4*)(rowp + bj * 128) = w; } }
    }
};
struct EpiSwiGLU8 {
    static constexpr bool PERM = true;
    unsigned char* H; int ldc;
    __device__ __forceinline__ void operator()(const f32x4 (&acc)[2][2][4][2], const pg8::Unit& u, int wr, int wc, int fr, int fq) const {
        const int row0 = u.pm * 256 + wr * 64 + fr, col0 = u.pn * 128 + wc * 32 + 8 * fq; const float is = 1.f / MOE_W13_SCALE;
#pragma unroll
        for (int ai = 0; ai < 2; ++ai)
#pragma unroll
            for (int m = 0; m < 4; ++m) { unsigned char* rowp = H + (size_t)(row0 + ai * 128 + m * 16) * ldc + col0;
                u32x2 w;
                { const f32x4 a = acc[ai][0][m][0] * is, b = acc[ai][0][m][1] * is; w.x = pk_fp8x4(silu_f(a[0]) * b[0], silu_f(a[1]) * b[1], silu_f(a[2]) * b[2], silu_f(a[3]) * b[3]); }
                { const f32x4 a = acc[ai][1][m][0] * is, b = acc[ai][1][m][1] * is; w.y = pk_fp8x4(silu_f(a[0]) * b[0], silu_f(a[1]) * b[1], silu_f(a[2]) * b[2], silu_f(a[3]) * b[3]); }
                *(u32x2*)rowp = w; }
    }
};
struct SchedMoeTail {
    static constexpr bool GATHER = false;
    int first, count; const char* Bt; int K; size_t estride; volatile LAS unsigned* M;
    __device__ __forceinline__ bool next(int i, pg8::Unit& u) const {
        if (i > 0 || first >= count) return false;
        const int sl = first % 7, rest = first / 7; u.pn = rest & 3; u.pm = 128 + (rest >> 2); u.pl = sl;
        int e = 0;
#pragma unroll
        for (int k = 1; k < NEXP; ++k) e += ((int)M[16 + k] <= u.pm) ? 1 : 0;
        u.e = __builtin_amdgcn_readfirstlane(e); return true;
    }
    __device__ __forceinline__ size_t a_tile(const pg8::Unit& u) const { return (size_t)u.pm * 256 * K * 2 + (size_t)u.pl * 512; }
    __device__ __forceinline__ void a_offs(const pg8::Unit&, const int (&)[2], const int (&)[2], unsigned (&)[2][2]) const {}
    __device__ __forceinline__ const char* b_tile(const pg8::Unit& u) const { return Bt + (size_t)u.e * estride + (size_t)u.pn * 256 * K * 2 + (size_t)u.pl * 512; }
};
struct EpiTailPart {
    static constexpr bool PERM = false;
    bf16_t* Yt; float scale;
    __device__ __forceinline__ void operator()(const f32x4 (&acc)[2][2][4][2], const pg8::Unit& u, int wr, int wc, int fr, int fq) const {
        const int row0 = u.pl * 2048 + (u.pm - 128) * 256 + wr * 64 + fr, col0 = u.pn * 256 + wc * 32 + 4 * fq;
#pragma unroll
        for (int ai = 0; ai < 2; ++ai)
#pragma unroll
            for (int m = 0; m < 4; ++m) { bf16_t* rowp = Yt + (size_t)(row0 + ai * 128 + m * 16) * D + col0;
#pragma unroll
                for (int bj = 0; bj < 2; ++bj)
#pragma unroll
                    for (int n = 0; n < 2; ++n) { const f32x4 v = acc[ai][bj][m][n] * scale; u32x2 w; w.x = cvt_pk_bf16(v[0], v[1]); w.y = cvt_pk_bf16(v[2], v[3]); *(u32x2*)(rowp + bj * 128 + n * 16) = w; } }
    }
};

struct ThinInProj {
    bf16_t* QKV; int col_off;
    __device__ __forceinline__ void operator()(int row, int col, const float (&v)[8]) const {
        const int c = col + col_off; const float sc = c < C_KA ? C2 : 1.f;
        u32x4 w; w.x = cvt_pk_bf16(v[0] * sc, v[1] * sc); w.y = cvt_pk_bf16(v[2] * sc, v[3] * sc); w.z = cvt_pk_bf16(v[4] * sc, v[5] * sc); w.w = cvt_pk_bf16(v[6] * sc, v[7] * sc);
        *(u32x4*)(QKV + (size_t)((row >> 8) * KVR + (row & 255)) * INC + c) = w;
    }
};
struct ThinResGate {
    const float* base; float* out; const float* gate;
    __device__ __forceinline__ void operator()(int row, int col, const float (&v)[8]) const {
        const size_t off = (size_t)row * D + col;
        const f32x4 g0 = *(const f32x4*)(gate + col), g1 = *(const f32x4*)(gate + col + 4), b0 = *(const f32x4*)(base + off), b1 = *(const f32x4*)(base + off + 4);
        *(f32x4*)(out + off) = b0 + g0 * (f32x4){v[0], v[1], v[2], v[3]}; *(f32x4*)(out + off + 4) = b1 + g1 * (f32x4){v[4], v[5], v[6], v[7]};
    }
};
struct ThinPartial {
    float* P;
    __device__ __forceinline__ void operator()(int row, int colk, const float (&v)[8]) const {
        const int kp = colk >> 20, col = colk & 0xFFFFF;
        float* o = P + ((size_t)kp * NCTX + row) * D + col;
        *(f32x4*)o = (f32x4){v[0], v[1], v[2], v[3]}; *(f32x4*)(o + 4) = (f32x4){v[4], v[5], v[6], v[7]};
    }
};
struct ThinSwiGLU {
    bf16_t* H; int ldc;
    __device__ __forceinline__ void operator()(int row, int col, const float (&v)[8]) const {
        u32x2 w; w.x = cvt_pk_bf16(silu_f(v[0]) * v[4], silu_f(v[1]) * v[5]); w.y = cvt_pk_bf16(silu_f(v[2]) * v[6], silu_f(v[3]) * v[7]);
        const int c = col & 255;
        *(u32x2*)(H + (size_t)row * ldc + (col >> 8) * 128 + 32 * ((c >> 5) & 3) + 8 * ((c >> 3) & 3) + 4 * (c >> 7)) = w;
    }
};
template <class Epi8>
__device__ __forceinline__ void thin_gemm(const Ctx& X0, const bf16_t* A, const bf16_t* Bt, int N, int K, const Epi8& E, int first, int stride, int ksplit = 1) {
    const Ctx X = fresh(X0);
    constexpr int PST = 68, TB = 16384;
    const int lane = X.lane, wid = X.wave, r32 = lane & 31, hi = lane >> 5, mi = wid & 1, ni = (wid >> 1) & 1, kh = wid >> 2;
    LAS char* L = (LAS char*)X.lds;
    LAS float* Pl = (LAS float*)(L + 4 * TB);
    const int srow = X.tid >> 3, sch = X.tid & 7;
    const int sw0 = srow * 256 + ((sch ^ (srow & 7)) * 16), sw1 = sw0 + 128;
    const int ra = 32 * mi + r32, rb = 32 * ni + r32, fa = ra * 256, fb = rb * 256, xa = ra & 7, xb = rb & 7;
    const int nTn = N / 64, klen = K / ksplit, nk = klen / 128;
    for (int wi = first; wi < 8 * nTn * ksplit; wi += stride) {
        const int tile = wi / ksplit, kp = wi - tile * ksplit;
        const int tm = tile & 7, tn = tile >> 3;
        const bf16_t* ag = A + (size_t)(tm * 64 + srow) * K + kp * klen + sch * 8; const bf16_t* bg = Bt + (size_t)(tn * 64 + srow) * K + kp * klen + sch * 8;
        bf16x8 ea0 = *(const bf16x8*)ag, ea1 = *(const bf16x8*)(ag + 64), eb0 = *(const bf16x8*)bg, eb1 = *(const bf16x8*)(bg + 64);
        bf16x8 oa0 = *(const bf16x8*)(ag + 128), oa1 = *(const bf16x8*)(ag + 192), ob0 = *(const bf16x8*)(bg + 128), ob1 = *(const bf16x8*)(bg + 192);
        f32x16 c = {};
#define THIN_COMPUTE(ta, tb) do { _Pragma("unroll") for (int jj = 0; jj < 4; ++jj) { const int ci = 2 * (4 * kh + jj) + hi; \
            const bf16x8 af = *(const LAS bf16x8*)((ta) + fa + ((ci ^ xa) * 16)), bf = *(const LAS bf16x8*)((tb) + fb + ((ci ^ xb) * 16)); \
            c = __builtin_amdgcn_mfma_f32_32x32x16_bf16(af, bf, c, 0, 0, 0); } } while (0)
        for (int s = 0; s < nk; s += 2) {
            LAS char* ta = L; LAS char* tb = L + 2 * TB;
            *(LAS bf16x8*)(ta + sw0) = ea0; *(LAS bf16x8*)(ta + sw1) = ea1; *(LAS bf16x8*)(tb + sw0) = eb0; *(LAS bf16x8*)(tb + sw1) = eb1;
            __syncthreads();
            if (s + 2 < nk) { const int ko = (s + 2) * 128; ea0 = *(const bf16x8*)(ag + ko); ea1 = *(const bf16x8*)(ag + ko + 64); eb0 = *(const bf16x8*)(bg + ko); eb1 = *(const bf16x8*)(bg + ko + 64); }
            THIN_COMPUTE(ta, tb);
            if (s + 1 < nk) {
            ta += TB; tb += TB;
            *(LAS bf16x8*)(ta + sw0) = oa0; *(LAS bf16x8*)(ta + sw1) = oa1; *(LAS bf16x8*)(tb + sw0) = ob0; *(LAS bf16x8*)(tb + sw1) = ob1;
            __syncthreads();
            if (s + 3 < nk) { const int ko = (s + 3) * 128; oa0 = *(const bf16x8*)(ag + ko); oa1 = *(const bf16x8*)(ag + ko + 64); ob0 = *(const bf16x8*)(bg + ko); ob1 = *(const bf16x8*)(bg + ko + 64); }
            THIN_COMPUTE(ta, tb); }
        }
#undef THIN_COMPUTE
        LAS float* pw = Pl + kh * 64 * PST + ni * 32 + r32;
#pragma unroll
        for (int r = 0; r < 16; ++r) pw[(32 * mi + (r & 3) + 8 * (r >> 2) + 4 * hi) * PST] = c[r];
        __syncthreads();
        { const int row = X.tid >> 3, c8 = (X.tid & 7) * 8; float v[8];
            const LAS float* pr = Pl + row * PST + c8;
            const f32x4 s0 = *(const LAS f32x4*)pr + *(const LAS f32x4*)(pr + 64 * PST), s1 = *(const LAS f32x4*)(pr + 4) + *(const LAS f32x4*)(pr + 64 * PST + 4);
            v[0] = s0[0]; v[1] = s0[1]; v[2] = s0[2]; v[3] = s0[3]; v[4] = s1[0]; v[5] = s1[1]; v[6] = s1[2]; v[7] = s1[3];
            E(tm * 64 + row, (tn * 64 + c8) | (kp << 20), v); }
        __syncthreads();
    }
}

__device__ __forceinline__ unsigned f2bf(float f) { unsigned u = __builtin_bit_cast(unsigned, f); return (u + 0x7fffu + ((u >> 16) & 1u)) >> 16; }
__device__ __forceinline__ unsigned pk2(float lo, float hi) { return f2bf(lo) | (f2bf(hi) << 16); }
template <int MODE> __device__ __forceinline__ int dest_row(int n) {
    if (MODE == 1) { if ((n >= C_QB && n < C_KA) || (n >= C_KB && n < C_VA)) { const int i = n & 63, base = n & ~63; return base + ((i < 32) ? 8 * (i >> 2) + (i & 3) : 8 * ((i - 32) >> 2) + 4 + (i & 3)); } return n; }
    if (MODE == 2) return 8 * (n >> 2) + (n & 3);
    if (MODE == 3) return 8 * (n >> 2) + 4 + (n & 3);
    return n;
}
__device__ __forceinline__ int dest_row_moe(int w3, int n) { const int o = n & 127; return (n >> 7) * 256 + 128 * ((o >> 2) & 1) + 32 * (o >> 5) + 8 * ((o >> 3) & 3) + 4 * w3 + (o & 3); }
template <int MODE> __device__ __forceinline__ void p0_transpose_item(const float* W, int K, int N, bf16_t* WT, LAS float* scr, int item, int lane) {
    const int nblk = N / 32, kb = item / nblk, nb = item % nblk, k0 = 64 * kb, n0 = 32 * nb;
#pragma unroll 8
    for (int i = 0; i < 32; ++i) { const int kk = 2 * i + (lane >> 5); scr[kk * 33 + (lane & 31)] = W[(size_t)(k0 + kk) * N + n0 + (lane & 31)]; }
    LDS_WAIT(); asm volatile("" ::: "memory");
    const int c = lane & 7;
#pragma unroll
    for (int j = 0; j < 4; ++j) { const int n = (lane >> 3) + 8 * j; const LAS float* s = scr + (8 * c) * 33 + n;
        u32x4 o; o.x = pk2(s[0 * 33], s[1 * 33]); o.y = pk2(s[2 * 33], s[3 * 33]); o.z = pk2(s[4 * 33], s[5 * 33]); o.w = pk2(s[6 * 33], s[7 * 33]);
        st16_wt(WT + (size_t)dest_row<MODE>(n0 + n) * K + k0 + 8 * c, o); }
    LDS_WAIT(); asm volatile("" ::: "memory");
}
template <int MODE> __device__ __forceinline__ void p0_transpose_item_f8(const float* W, int K, int N, unsigned char* WT8, float scale, LAS float* scr, int item, int lane) {
    const int nblk = N / 32, kb = item / nblk, nb = item % nblk, k0 = 64 * kb, n0 = 32 * nb;
#pragma unroll 8
    for (int i = 0; i < 32; ++i) { const int kk = 2 * i + (lane >> 5); scr[kk * 33 + (lane & 31)] = W[(size_t)(k0 + kk) * N + n0 + (lane & 31)] * scale; }
    LDS_WAIT(); asm volatile("" ::: "memory");
    const int c = lane & 7;
#pragma unroll
    for (int j = 0; j < 4; ++j) { const int n = (lane >> 3) + 8 * j; const LAS float* q = scr + (8 * c) * 33 + n;
        u32x2 o; o.x = pk_fp8x4(q[0 * 33], q[1 * 33], q[2 * 33], q[3 * 33]); o.y = pk_fp8x4(q[4 * 33], q[5 * 33], q[6 * 33], q[7 * 33]);
        st8_wt(WT8 + (size_t)dest_row<MODE>(n0 + n) * K + k0 + 8 * c, o); }
    LDS_WAIT(); asm volatile("" ::: "memory");
}
__device__ __forceinline__ void sincos_d(double x, double& s, double& c) {
    const double k = __builtin_rint(x * 0.63661977236758134308);
    double r = __builtin_fma(-k, 1.57079632679489655800e+00, x); r = __builtin_fma(-k, 6.12323399573676603587e-17, r);
    const double r2 = r * r;
    double sp = -7.6471637318198164759e-13; sp = sp * r2 + 1.6059043836821614599e-10; sp = sp * r2 - 2.5052108385441718775e-08; sp = sp * r2 + 2.7557319223985890653e-06;
    sp = sp * r2 - 1.9841269841269841270e-04; sp = sp * r2 + 8.3333333333333333333e-03; sp = sp * r2 - 1.6666666666666666667e-01; const double sr = r + r * r2 * sp;
    double cp = 4.7794773323873852974e-14; cp = cp * r2 - 1.1470745597729724714e-11; cp = cp * r2 + 2.0876756987868098979e-09; cp = cp * r2 - 2.7557319223985890653e-07;
    cp = cp * r2 + 2.4801587301587301587e-05; cp = cp * r2 - 1.3888888888888888889e-03; cp = cp * r2 + 4.1666666666666666667e-02; cp = cp * r2 - 0.5; const double cr = 1.0 + r2 * cp;
    const int q = ((int)k) & 3;
    s = (q == 0) ? sr : (q == 1) ? cr : (q == 2) ? -sr : -cr;
    c = (q == 0) ? cr : (q == 1) ? -sr : (q == 2) ? -cr : sr;
}
__device__ __forceinline__ float inv_freq(int f) {
    float v = (f & 3) == 0 ? 1.0f : (f & 3) == 1 ? 0.5623413251903491f : (f & 3) == 2 ? 0.31622776601683794f : 0.1778279410038923f;
    const int d = f >> 2; v *= (d == 0) ? 1.0f : (d == 1) ? 0.1f : (d == 2) ? 0.01f : 0.001f; return v;
}
struct P0D { const float* W; unsigned char* WT; int K, N, item, mode, f8; float scale; };
constexpr int I_IN = 16 * 96, I_OUT = 16 * 32, I_F13 = 16 * 88, I_F2 = 44 * 32, I_M13 = 16 * 112, I_M2 = 56 * 32;
constexpr int P0_NITEMS = 2 * I_IN + 2 * I_OUT + 2 * I_F13 + I_F2 + 16 * I_M13 + 8 * I_M2;
__device__ __forceinline__ P0D p0_decode(const Ctx& X, const Params& P, int it) {
    P0D d; int r = it; d.scale = 1.f; d.f8 = 0;
    if (r < 2 * I_IN) { const int l = r / I_IN; d.W = P.w_in + (size_t)l * D * INC; d.K = D; d.N = INC; d.WT = X.ws + WS_WIN + (size_t)l * INC * D * 2; d.mode = 1; d.item = r % I_IN; return d; } r -= 2 * I_IN;
    if (r < 2 * I_OUT) { const int l = r / I_OUT; d.W = P.w_out + (size_t)l * D * D; d.K = D; d.N = D; d.WT = X.ws + WS_WOUT + (size_t)l * D * D * 2; d.mode = 0; d.item = r % I_OUT; return d; } r -= 2 * I_OUT;
    if (r < I_F13) { d.W = P.ffn_w1; d.K = D; d.N = DFF; d.WT = X.ws + WS_W13; d.mode = 4; d.item = r; return d; } r -= I_F13;
    if (r < I_F13) { d.W = P.ffn_w3; d.K = D; d.N = DFF; d.WT = X.ws + WS_W13; d.mode = 5; d.item = r; return d; } r -= I_F13;
    if (r < I_F2) { d.W = P.ffn_w2; d.K = DFF; d.N = D; d.WT = X.ws + WS_W2; d.mode = 0; d.item = r; return d; } r -= I_F2;
    d.f8 = 1;
    if (r < 8 * I_M13) { const int e = r / I_M13; d.W = P.moe_w1 + (size_t)e * D * DEXP; d.K = D; d.N = DEXP; d.WT = X.ws + WS_MW13 + (size_t)e * 2 * DEXP * D; d.mode = 4; d.item = r % I_M13; d.scale = MOE_W13_SCALE; return d; } r -= 8 * I_M13;
    if (r < 8 * I_M13) { const int e = r / I_M13; d.W = P.moe_w3 + (size_t)e * D * DEXP; d.K = D; d.N = DEXP; d.WT = X.ws + WS_MW13 + (size_t)e * 2 * DEXP * D; d.mode = 5; d.item = r % I_M13; d.scale = MOE_W13_SCALE; return d; } r -= 8 * I_M13;
    { const int e = r / I_M2; d.W = P.moe_w2 + (size_t)e * DEXP * D; d.K = DEXP; d.N = D; d.WT = X.ws + WS_MW2 + (size_t)e * D * DEXP; d.mode = 0; d.item = r % I_M2; d.scale = MOE_W2_SCALE; return d; }
}
__device__ __forceinline__ void p0_prologue(const Ctx& X0, const Params& P) {
    const Ctx X = fresh(X0);
    LAS float* scr = (LAS float*)(X.lds + X.wave * 16384);
    const int gw = X.vcu * NWAVES + X.wave, NGW = X.G * NWAVES;
    float vn[32];
    constexpr int MOD_ITEMS = 2 * (6 * D / 64);
    if (X.vcu < MOD_ITEMS) {
        LAS float* sv = (LAS float*)(X.lds);
        LAS float* red = (LAS float*)(X.lds + 16384);
        for (int i = X.tid; i < 3 * D; i += NWAVES * 64) { const int v = i / D, k = i % D; const float cv = v < 2 ? P.c[v * D + k] : P.c_ctx[k]; sv[i] = cv / (1.f + __expf(-cv)); }
        __syncthreads();
        const int l = X.vcu / 96, n0 = (X.vcu % 96) * 64;
        const int kg = X.tid >> 4, cl = X.tid & 15;
        const float* W = P.ada_w + (size_t)l * D * 6 * D + n0 + cl * 4;
        f32x4 a0 = {0.f, 0.f, 0.f, 0.f}, a1 = a0, a2 = a0;
#pragma unroll 8
        for (int kk = 0; kk < 32; ++kk) { const int k = kg * 32 + kk; const f32x4 w = *(const f32x4*)(W + (size_t)k * 6 * D); a0 += w * sv[k]; a1 += w * sv[D + k]; a2 += w * sv[2 * D + k]; }
#pragma unroll
        for (int j = 0; j < 4; ++j) { red[(kg * 3 + 0) * 64 + cl * 4 + j] = a0[j]; red[(kg * 3 + 1) * 64 + cl * 4 + j] = a1[j]; red[(kg * 3 + 2) * 64 + cl * 4 + j] = a2[j]; }
        __syncthreads();
        if (X.tid < 192) { const int v = X.tid / 64, cc = X.tid % 64; float s = 0.f;
            for (int g = 0; g < 32; ++g) s += red[(g * 3 + v) * 64 + cc];
            ((float*)(X.ws + WS_MODS))[(size_t)(l * 3 + v) * 6 * D + n0 + cc] = s + P.ada_b[l * 6 * D + n0 + cc]; }
        __syncthreads();
    } else if (X.vcu == MOD_ITEMS) {
        f32x2* tabR = (f32x2*)(X.ws + WS_TABR); f32x2* tabC = (f32x2*)(X.ws + WS_TABC);
        for (int i = X.tid; i < 192 * 16; i += NWAVES * 64) { const int pos = i >> 4, f = i & 15; const int p = pos < 128 ? pos : pos - 128;
            const float ang = (float)p * inv_freq(f); double s, c; sincos_d((double)ang, s, c);
            const f32x2 cs = {(float)c, (float)s}; if (pos < 128) tabR[pos * 16 + f] = cs; else tabC[(pos - 128) * 16 + f] = cs; }
        if (X.wave < 2) { const float* dl = P.diff_lambda + X.wave * 256;
            const float s1 = wave_sum(dl[X.lane] * dl[64 + X.lane]), s2 = wave_sum(dl[128 + X.lane] * dl[192 + X.lane]);
            const float linit = X.wave == 0 ? 0.2f : (0.8f - 0.6f * 0.74081822068171786607f);
            if (X.lane == 0) ((float*)(X.ws + WS_LAM))[X.wave] = __expf(s1) - __expf(s2) + linit; }
    }
    for (int it = gw; it < P0_NITEMS; ) {
        const P0D d = p0_decode(X, P, it);
        const int nblk = d.N / 32, kb = d.item / nblk, nb = d.item % nblk, k0 = 64 * kb, n0 = 32 * nb;
        float v[32];
        if (it == gw) { const float* src = d.W + (size_t)(k0 + (X.lane >> 5)) * d.N + n0 + (X.lane & 31);
#pragma unroll
            for (int i = 0; i < 32; ++i) v[i] = __builtin_nontemporal_load(src + (size_t)(2 * i) * d.N); }
        else {
#pragma unroll
            for (int i = 0; i < 32; ++i) v[i] = vn[i]; }
#pragma unroll
        for (int i = 0; i < 32; ++i) scr[(2 * i + (X.lane >> 5)) * 33 + (X.lane & 31)] = v[i] * d.scale;
        LDS_WAIT(); asm volatile("" ::: "memory");
        const int itn = it + NGW;
        if (itn < P0_NITEMS) { const P0D dn = p0_decode(X, P, itn);
            const int nblkn = dn.N / 32, kbn = dn.item / nblkn, nbn = dn.item % nblkn;
            const float* src = dn.W + (size_t)(64 * kbn + (X.lane >> 5)) * dn.N + 32 * nbn + (X.lane & 31);
#pragma unroll
            for (int i = 0; i < 32; ++i) vn[i] = __builtin_nontemporal_load(src + (size_t)(2 * i) * dn.N); }
        const int c = X.lane & 7;
#pragma unroll
        for (int j = 0; j < 4; ++j) { const int n = (X.lane >> 3) + 8 * j; const LAS float* q = scr + (8 * c) * 33 + n;
            const int dr = d.mode == 1 ? dest_row<1>(n0 + n) : d.mode == 2 ? dest_row<2>(n0 + n) : d.mode == 3 ? dest_row<3>(n0 + n) : d.mode >= 4 ? dest_row_moe(d.mode - 4, n0 + n) : n0 + n;
            const size_t eo = (size_t)dr * d.K + k0 + 8 * c;
            if (d.f8) { u32x2 o; o.x = pk_fp8x4(q[0 * 33], q[1 * 33], q[2 * 33], q[3 * 33]); o.y = pk_fp8x4(q[4 * 33], q[5 * 33], q[6 * 33], q[7 * 33]); st8_wt(d.WT + eo, o); }
            else { u32x4 o; o.x = pk2(q[0 * 33], q[1 * 33]); o.y = pk2(q[2 * 33], q[3 * 33]); o.z = pk2(q[4 * 33], q[5 * 33]); o.w = pk2(q[6 * 33], q[7 * 33]); st16_wt(d.WT + 2 * eo, o); } }
        LDS_WAIT(); asm volatile("" ::: "memory");
        it = itn;
    }
}

__device__ __forceinline__ void norm_phase(const Ctx& X0, const float* xlat, const float* xctx, const float* shift0, const float* scale0, bf16_t* H, int rows, const float* cpart = nullptr, const float* cgate = nullptr, float* cwrite = nullptr) {
    const Ctx X = fresh(X0);
    const int gw = X.vcu * NWAVES + X.wave, NGW = X.G * NWAVES;
#define NP_V(m_) ((m_) < SEQ ? 0 : ((m_) < NLAT ? 1 : 2))
#define NP_SRC(m_) ((const GAS f32x4*)((m_) < NLAT ? xlat + (size_t)(m_) * D : xctx + (size_t)((m_) - NLAT) * D) + X.lane)
    for (int m0 = gw; m0 < rows; m0 += 4 * NGW) {
        const int ml = m0 + 3 * NGW, v0 = NP_V(m0);
        if (ml < rows && NP_V(ml) == v0 && (cpart == nullptr || ml < NLAT)) {
            f32x4 xv[4][4], sh[4], sc[4]; float s2[4];
#pragma unroll
            for (int r = 0; r < 4; ++r) { const int m = m0 + r * NGW; const GAS f32x4* xr = NP_SRC(m);
#pragma unroll
                for (int j = 0; j < 4; ++j) xv[r][j] = xr[64 * j]; }
            const f32x4* shp = (const f32x4*)(shift0 + (size_t)v0 * 6 * D) + X.lane; const f32x4* scp = (const f32x4*)(scale0 + (size_t)v0 * 6 * D) + X.lane;
#pragma unroll
            for (int j = 0; j < 4; ++j) { sh[j] = shp[64 * j]; sc[j] = scp[64 * j] + 1.f; }
#pragma unroll
            for (int r = 0; r < 4; ++r) { s2[r] = 0.f;
#pragma unroll
                for (int j = 0; j < 4; ++j) s2[r] += (xv[r][j].x * xv[r][j].x + xv[r][j].y * xv[r][j].y) + (xv[r][j].z * xv[r][j].z + xv[r][j].w * xv[r][j].w); }
#pragma unroll
            for (int r = 0; r < 4; ++r) s2[r] = 1.f / sqrtf(wave_sum(s2[r]) * (1.f / D) + EPS);
#pragma unroll
            for (int r = 0; r < 4; ++r) { GAS u32x2* o8 = (GAS u32x2*)(H + (size_t)(m0 + r * NGW) * D) + X.lane;
#pragma unroll
                for (int j = 0; j < 4; ++j) { const f32x4 h = xv[r][j] * s2[r] * sc[j] + sh[j];
                    u32x2 w; w.x = cvt_pk_bf16(h.x, h.y); w.y = cvt_pk_bf16(h.z, h.w); st8_wt((void*)(o8 + 64 * j), w); } }
        } else {
            for (int m = m0; m < rows && m <= ml; m += NGW) {
                const int v = NP_V(m);
                const GAS f32x4* xr = NP_SRC(m);
                const f32x4* shp = (const f32x4*)(shift0 + (size_t)v * 6 * D) + X.lane; const f32x4* scp = (const f32x4*)(scale0 + (size_t)v * 6 * D) + X.lane;
                f32x4 xv[4]; float s2 = 0.f;
#pragma unroll
                for (int j = 0; j < 4; ++j) { xv[j] = xr[64 * j];
                    if (cpart != nullptr && m >= NLAT) { const f32x4* pp = (const f32x4*)(cpart + (size_t)(m - NLAT) * D) + X.lane; xv[j] += ((const f32x4*)cgate + X.lane)[64 * j] * (pp[64 * j] + pp[(size_t)NCTX * D / 4 + 64 * j]);
                        if (cwrite != nullptr) ((f32x4*)(cwrite + (size_t)(m - NLAT) * D) + X.lane)[64 * j] = xv[j]; }
                    s2 += (xv[j].x * xv[j].x + xv[j].y * xv[j].y) + (xv[j].z * xv[j].z + xv[j].w * xv[j].w); }
                const float rstd = 1.f / sqrtf(wave_sum(s2) * (1.f / D) + EPS);
                GAS u32x2* o8 = (GAS u32x2*)(H + (size_t)m * D) + X.lane;
#pragma unroll
                for (int j = 0; j < 4; ++j) { const f32x4 sh = shp[64 * j], sc = scp[64 * j]; const f32x4 h = xv[j] * rstd * (sc + 1.f) + sh;
                    u32x2 w; w.x = cvt_pk_bf16(h.x, h.y); w.y = cvt_pk_bf16(h.z, h.w); st8_wt((void*)(o8 + 64 * j), w); }
            }
        }
    }
#undef NP_V
#undef NP_SRC
}

__device__ __forceinline__ void conv_phase(const Ctx& X0, const bf16_t* QKV, bf16_t* CAT, const float* cw, int rows, int skip = 0) {
    const Ctx X = fresh(X0);
    if (X.vcu < skip) return;
    const int gt = (X.vcu - skip) * (NWAVES * 64) + X.tid, NT = (X.G - skip) * NWAVES * 64;
    for (int it = gt; it < rows * 32; it += NT) {
        const int m = it >> 5, c8 = (it & 31) * 8;
        int b, t, n, R;
        if (m < NLAT) { b = m >> 13; t = m & (SEQ - 1); n = SEQ; R = b * KVR + CTXL + t; } else { const int mm = m - NLAT; b = mm >> 8; t = mm & (CTXL - 1); n = CTXL; R = b * KVR + t; }
        float acc[8];
#pragma unroll
        for (int j = 0; j < 8; ++j) acc[j] = 0.f;
#pragma unroll
        for (int dt = -1; dt <= 1; ++dt) {
            if (t + dt < 0 || t + dt >= n) continue;
            const bf16_t* rp = QKV + (size_t)(R + dt) * INC;
            const bf16x8 xi = *(const bf16x8*)(rp + C_XIN + c8), cg = *(const bf16x8*)(rp + C_CG + c8);
            const float* w = cw + (dt + 1) * 256 + c8;
#pragma unroll
            for (int j = 0; j < 8; ++j) acc[j] += w[j] * (bf2f((unsigned short)xi[j]) * bf2f((unsigned short)cg[j]));
        }
        const bf16x8 bg = *(const bf16x8*)(QKV + (size_t)R * INC + C_BG + c8);
        u32x4 o;
        o.x = cvt_pk_bf16(acc[0] * bf2f((unsigned short)bg[0]), acc[1] * bf2f((unsigned short)bg[1])); o.y = cvt_pk_bf16(acc[2] * bf2f((unsigned short)bg[2]), acc[3] * bf2f((unsigned short)bg[3]));
        o.z = cvt_pk_bf16(acc[4] * bf2f((unsigned short)bg[4]), acc[5] * bf2f((unsigned short)bg[5])); o.w = cvt_pk_bf16(acc[6] * bf2f((unsigned short)bg[6]), acc[7] * bf2f((unsigned short)bg[7]));
        *(u32x4*)(CAT + (size_t)m * D + 768 + c8) = o;
    }
}

namespace att {
constexpr int KCH = 1040;
constexpr int KT_BYTES = 8 * KCH;
constexpr float THR = 8.f;
__device__ __forceinline__ int crow(int r, int hi) { return (r & 3) + 8 * (r >> 2) + 4 * hi; }
template <int W> __device__ __forceinline__ int v_st(int k, int c) { const int kk = (k & ~0xC) | ((k & 4) << 1) | ((k & 8) >> 1); return ((kk >> 3) * W + (c >> 5)) * 512 + ((kk & 7) * 32 + (c & 31)) * 2; }
template <int W> __device__ __forceinline__ int v_st_nat(int k, int c) { return ((k >> 3) * W + (c >> 5)) * 512 + ((k & 7) * 32 + (c & 31)) * 2; }
__device__ __forceinline__ int v_rd_base(int lane) { return ((lane & 3) << 3) | (((lane >> 2) & 3) << 6) | (((lane >> 4) & 1) << 5) | (((lane >> 5) & 1) << 8); }
template <int OFF> __device__ __forceinline__ s16x4 tr_read(int vb) { s16x4 r; asm volatile("ds_read_b64_tr_b16 %0, %1 offset:%2" : "=&v"(r) : "v"(vb), "i"(OFF) : "memory"); return r; }
template <int D0, int W> __device__ __forceinline__ void pv_one(f32x16& od, int vb, bf16x8 pa0, bf16x8 pa1, bf16x8 pa2, bf16x8 pa3) {
    constexpr int KS = W * 1024, HF = W * 512, B = D0 * 512;
    const s16x4 l0 = tr_read<B>(vb), h0 = tr_read<B + HF>(vb), l1 = tr_read<B + KS>(vb), h1 = tr_read<B + KS + HF>(vb);
    const s16x4 l2 = tr_read<B + 2 * KS>(vb), h2 = tr_read<B + 2 * KS + HF>(vb), l3 = tr_read<B + 3 * KS>(vb), h3 = tr_read<B + 3 * KS + HF>(vb);
    asm volatile("s_waitcnt lgkmcnt(0)" ::: "memory"); __builtin_amdgcn_sched_barrier(0);
#define ATT_PK(L, H) (bf16x8){L[0], L[1], L[2], L[3], H[0], H[1], H[2], H[3]}
    od = __builtin_amdgcn_mfma_f32_32x32x16_bf16(pa0, ATT_PK(l0, h0), od, 0, 0, 0);
    od = __builtin_amdgcn_mfma_f32_32x32x16_bf16(pa1, ATT_PK(l1, h1), od, 0, 0, 0);
    od = __builtin_amdgcn_mfma_f32_32x32x16_bf16(pa2, ATT_PK(l2, h2), od, 0, 0, 0);
    od = __builtin_amdgcn_mfma_f32_32x32x16_bf16(pa3, ATT_PK(l3, h3), od, 0, 0, 0);
#undef ATT_PK
}
__device__ __forceinline__ void qkt64(f32x16& p0, f32x16& p1, const LAS char* Ks, const bf16x8 (&qr)[4], int r32, int hi) {
    const LAS char* kb = Ks + hi * KCH + r32 * 16;
    p0 = (f32x16){}; p1 = (f32x16){};
#pragma unroll
    for (int d0 = 0; d0 < 4; ++d0) {
        const bf16x8 b0 = *(const LAS bf16x8*)(kb + d0 * 2 * KCH), b1 = *(const LAS bf16x8*)(kb + d0 * 2 * KCH + 512);
        p0 = __builtin_amdgcn_mfma_f32_32x32x16_bf16(b0, qr[d0], p0, 0, 0, 0);
        p1 = __builtin_amdgcn_mfma_f32_32x32x16_bf16(b1, qr[d0], p1, 0, 0, 0); }
}
__device__ __forceinline__ void qkt64s(f32x16& p0, f32x16& p1, const LAS char* kb, int kx, const bf16x8 (&qr)[4]) {
    p0 = (f32x16){}; p1 = (f32x16){};
#pragma unroll
    for (int d0 = 0; d0 < 4; ++d0) {
        const bf16x8 b0 = *(const LAS bf16x8*)(kb + (kx ^ (32 * d0))), b1 = *(const LAS bf16x8*)(kb + (kx ^ (32 * d0)) + 4096);
        p0 = __builtin_amdgcn_mfma_f32_32x32x16_bf16(b0, qr[d0], p0, 0, 0, 0);
        p1 = __builtin_amdgcn_mfma_f32_32x32x16_bf16(b1, qr[d0], p1, 0, 0, 0); }
}
__device__ __forceinline__ void softmax_tile(f32x16& p0, f32x16& p1, float& m_reg, float& l_reg, float& alpha, bf16x8& pa0, bf16x8& pa1, bf16x8& pa2, bf16x8& pa3) {
    float pmax = p0[0];
#pragma unroll
    for (int r = 1; r < 16; ++r) pmax = fmaxf(pmax, p0[r]);
#pragma unroll
    for (int r = 0; r < 16; ++r) pmax = fmaxf(pmax, p1[r]);
    { auto rr = __builtin_amdgcn_permlane32_swap(__float_as_uint(pmax), __float_as_uint(pmax), false, false); pmax = fmaxf(__uint_as_float(rr[0]), __uint_as_float(rr[1])); }
    float mn;
    if (__builtin_expect(__all(pmax - m_reg <= THR), 1)) { mn = m_reg; alpha = 1.f; }
    else { mn = fmaxf(m_reg, pmax); alpha = __builtin_amdgcn_exp2f(m_reg - mn); m_reg = mn; }
    float ps = 0.f;
#pragma unroll
    for (int r = 0; r < 16; ++r) { p0[r] = __builtin_amdgcn_exp2f(p0[r] - mn); ps += p0[r]; }
#pragma unroll
    for (int r = 0; r < 16; ++r) { p1[r] = __builtin_amdgcn_exp2f(p1[r] - mn); ps += p1[r]; }
    { auto rr = __builtin_amdgcn_permlane32_swap(__float_as_uint(ps), __float_as_uint(ps), false, false); ps = __uint_as_float(rr[0]) + __uint_as_float(rr[1]); }
    l_reg = l_reg * alpha + ps;
#define ATT_PK4(P, BASE, OUT) do { const unsigned a0 = cvt_pk_bf16(P[BASE + 0], P[BASE + 1]), a1 = cvt_pk_bf16(P[BASE + 2], P[BASE + 3]); \
    const unsigned b0 = cvt_pk_bf16(P[BASE + 4], P[BASE + 5]), b1 = cvt_pk_bf16(P[BASE + 6], P[BASE + 7]); \
    auto r0 = __builtin_amdgcn_permlane32_swap(a0, b0, false, false); auto r1 = __builtin_amdgcn_permlane32_swap(a1, b1, false, false); \
    u32x4 w = {r0[0], r1[0], r0[1], r1[1]}; OUT = __builtin_bit_cast(bf16x8, w); } while (0)
    ATT_PK4(p0, 0, pa0); ATT_PK4(p0, 8, pa1); ATT_PK4(p1, 0, pa2); ATT_PK4(p1, 8, pa3);
#undef ATT_PK4
}

template <bool CTXQ>
__device__ __forceinline__ void diff_unit_safe(const Ctx& X0, const bf16_t* QKV, bf16_t* CAT, int b, int hd, int qblk, float lam, const float* gain, float oscale) {
    const Ctx X = fresh(X0);
    constexpr int K_OFF = 0, V_OFF = 4 * KT_BYTES  , WS_OFF = V_OFF + 2 * 16384  ;
    const int tid = X.tid, lane = X.lane, wid = X.wave, r32 = lane & 31, hi = lane >> 5, jh = wid >> 2, qsub = wid & 3;
    LAS char* L = (LAS char*)X.lds;
    LAS float* wsf = (LAS float*)(L + WS_OFF) + wid * 64;
    const int NT = CTXQ ? CTXL / 64 : KVR / 64;
    const int kbase = b * KVR;
    const int qrow = b * KVR + (CTXQ ? 0 : CTXL) + qblk * 128 + qsub * 32 + r32;
    bf16x8 qr[4];
#pragma unroll
    for (int d0 = 0; d0 < 4; ++d0) qr[d0] = *(const bf16x8*)(QKV + (size_t)qrow * INC + C_QB + (2 * hd + jh) * 64 + d0 * 16 + hi * 8);
    const int khh = tid >> 8, kr = (tid >> 3) & 31, kc = tid & 7;
    const bf16_t* kg = QKV + (size_t)(kbase + kr) * INC + C_KB + (2 * hd + khh) * 64 + kc * 8;
    const int kl = K_OFF + khh * KT_BYTES + kc * KCH + kr * 16;
    const int sr = tid >> 4, sc = (tid & 15) * 8;
    const bf16_t* vg = QKV + (size_t)(kbase + sr) * INC + C_VB + hd * 128 + sc;
    const int vl0 = V_OFF + v_st<4>(sr, sc), vl1 = V_OFF + v_st<4>(32 + sr, sc);
    const int vb0 = (int)(uintptr_t)X.ldsg + V_OFF + v_rd_base(lane);
    const int ka0 = (int)(uintptr_t)X.ldsg + K_OFF + jh * KT_BYTES + hi * KCH + r32 * 16;
    bf16x8 ks0, ks1, vs0, vs1;
#define DF_SLOAD(t) do { const size_t go = (size_t)(t) * 64 * INC; ks0 = *(const bf16x8*)(kg + go); ks1 = *(const bf16x8*)(kg + go + 32 * INC); vs0 = *(const bf16x8*)(vg + go); vs1 = *(const bf16x8*)(vg + go + 32 * INC); } while (0)
#define DF_SWRITE(buf) do { *(LAS bf16x8*)(L + kl + (buf) * 2 * KT_BYTES) = ks0; *(LAS bf16x8*)(L + kl + (buf) * 2 * KT_BYTES + 512) = ks1; \
        *(LAS bf16x8*)(L + vl0 + (buf) * 16384) = vs0; *(LAS bf16x8*)(L + vl1 + (buf) * 16384) = vs1; } while (0)
    float m_reg = -1e30f, l_reg = 0.f; f32x16 o[4] = {};
    DF_SLOAD(0); VM_WAIT(); DF_SWRITE(0);
    for (int t = 0; t < NT; ++t) {
        const int buf = t & 1;
        __syncthreads();
        if (t + 1 < NT) DF_SLOAD(t + 1);
        float alpha; bf16x8 pa0, pa1, pa2, pa3;
        bf16x8 kf[8]; s16x4 vl[16], vh[16]; f32x16 p0 = {}, p1 = {};
        { const int ka = ka0 + buf * 2 * KT_BYTES, vb = vb0 + buf * 16384;
#pragma unroll
          for (int i = 0; i < 8; ++i) asm volatile("ds_read_b128 %0, %1 offset:%2" : "=&v"(kf[i]) : "v"(ka), "i"((i >> 1) * 2 * KCH + (i & 1) * 512) : "memory");
#define DF_VRD(i) do { asm volatile("ds_read_b64_tr_b16 %0, %1 offset:%2" : "=&v"(vl[i]) : "v"(vb), "i"(((i) >> 2) * 512 + ((i) & 3) * 4096) : "memory"); \
                       asm volatile("ds_read_b64_tr_b16 %0, %1 offset:%2" : "=&v"(vh[i]) : "v"(vb), "i"(((i) >> 2) * 512 + ((i) & 3) * 4096 + 2048) : "memory"); } while (0)
#pragma unroll
          for (int i = 0; i < 7; ++i) DF_VRD(i);
          asm volatile("s_waitcnt lgkmcnt(14)" ::: "memory"); __builtin_amdgcn_sched_barrier(0);
#pragma unroll
          for (int d0 = 0; d0 < 4; ++d0) { p0 = __builtin_amdgcn_mfma_f32_32x32x16_bf16(kf[2 * d0], qr[d0], p0, 0, 0, 0); p1 = __builtin_amdgcn_mfma_f32_32x32x16_bf16(kf[2 * d0 + 1], qr[d0], p1, 0, 0, 0); }
#pragma unroll
          for (int i = 7; i < 16; ++i) DF_VRD(i);
#undef DF_VRD
        }
        softmax_tile(p0, p1, m_reg, l_reg, alpha, pa0, pa1, pa2, pa3);
        if (__any(alpha < 1.f)) { if (hi == 0) wsf[r32] = alpha; LDS_WAIT();
#pragma unroll
            for (int d = 0; d < 4; ++d)
#pragma unroll
                for (int r = 0; r < 16; ++r) o[d][r] *= wsf[crow(r, hi)]; }
        asm volatile("s_waitcnt lgkmcnt(0)" ::: "memory"); __builtin_amdgcn_sched_barrier(0);
#define DF_PK(i) (bf16x8){vl[i][0], vl[i][1], vl[i][2], vl[i][3], vh[i][0], vh[i][1], vh[i][2], vh[i][3]}
#pragma unroll
        for (int d0 = 0; d0 < 4; ++d0) {
            o[d0] = __builtin_amdgcn_mfma_f32_32x32x16_bf16(pa0, DF_PK(d0 * 4 + 0), o[d0], 0, 0, 0); o[d0] = __builtin_amdgcn_mfma_f32_32x32x16_bf16(pa1, DF_PK(d0 * 4 + 1), o[d0], 0, 0, 0);
            o[d0] = __builtin_amdgcn_mfma_f32_32x32x16_bf16(pa2, DF_PK(d0 * 4 + 2), o[d0], 0, 0, 0); o[d0] = __builtin_amdgcn_mfma_f32_32x32x16_bf16(pa3, DF_PK(d0 * 4 + 3), o[d0], 0, 0, 0); }
#undef DF_PK
        if (t + 1 < NT) { VM_WAIT(); DF_SWRITE(buf ^ 1); }
    }
#undef DF_SLOAD
#undef DF_SWRITE
    if (hi == 0) wsf[32 + r32] = l_reg; LDS_WAIT();
    float rli[16];
#pragma unroll
    for (int r = 0; r < 16; ++r) rli[r] = __builtin_amdgcn_rcpf(wsf[32 + crow(r, hi)]);
#pragma unroll
    for (int d = 0; d < 4; ++d)
#pragma unroll
        for (int r = 0; r < 16; ++r) o[d][r] *= rli[r];
    __syncthreads();
    LAS float* XO = (LAS float*)L + qsub * 4096;
    if (jh == 1) {
#pragma unroll
        for (int d = 0; d < 4; ++d)
#pragma unroll
            for (int r = 0; r < 16; ++r) XO[crow(r, hi) * 128 + d * 32 + r32] = o[d][r];
    }
    __syncthreads();
    if (jh == 0) {
        float ss[16];
#pragma unroll
        for (int r = 0; r < 16; ++r) { float s = 0.f;
#pragma unroll
            for (int d = 0; d < 4; ++d) { const float v = o[d][r] - lam * XO[crow(r, hi) * 128 + d * 32 + r32]; o[d][r] = v; s += v * v; }
            ss[r] = s; }
#pragma unroll
        for (int r = 0; r < 16; ++r) {
#pragma unroll
            for (int off = 1; off < 32; off <<= 1) ss[r] += __shfl_xor(ss[r], off);
            ss[r] = oscale / sqrtf(ss[r] * (1.f / 128.f) + EPS); }
        const int orow0 = (CTXQ ? NLAT + b * CTXL : b * SEQ) + qblk * 128 + qsub * 32;
#pragma unroll
        for (int d = 0; d < 4; ++d) { const float g = gain[d * 32 + r32];
#pragma unroll
            for (int r = 0; r < 16; ++r) CAT[(size_t)(orow0 + crow(r, hi)) * D + 256 + hd * 128 + d * 32 + r32] = (bf16_t)f2bf(o[d][r] * ss[r] * g); }
    }
    __syncthreads();
}

template <bool CTXQ>
__device__ __forceinline__ void diff_unit_fast(const Ctx& X0, const bf16_t* QKV, bf16_t* CAT, int b, int hd, int qblk, float lam, const float* gain, float oscale) {
    const Ctx X = fresh(X0);
    constexpr int K_OFF = 0, V_OFF = 4 * KT_BYTES  , WS_OFF = V_OFF + 2 * 16384  ;
    const int tid = X.tid, lane = X.lane, wid = X.wave, r32 = lane & 31, hi = lane >> 5, jh = wid >> 2, qsub = wid & 3;
    LAS char* L = (LAS char*)X.lds;
    LAS float* wsf = (LAS float*)(L + WS_OFF) + wid * 64;
    const int NT = CTXQ ? CTXL / 64 : KVR / 64;
    const int kbase = b * KVR;
    const int qrow = b * KVR + (CTXQ ? 0 : CTXL) + qblk * 128 + qsub * 32 + r32;
    bf16x8 qr[4];
#pragma unroll
    for (int d0 = 0; d0 < 4; ++d0) qr[d0] = *(const bf16x8*)(QKV + (size_t)qrow * INC + C_QB + (2 * hd + jh) * 64 + d0 * 16 + hi * 8);
    const int khh = tid >> 8, kr = (tid >> 3) & 31, kc = tid & 7;
    const bf16_t* kg = QKV + (size_t)(kbase + kr) * INC + C_KB + (2 * hd + khh) * 64 + kc * 8;
    const int kl = K_OFF + khh * KT_BYTES + kc * KCH + kr * 16;
    const int sr = tid >> 4, sc = (tid & 15) * 8;
    const bf16_t* vg_ = QKV + (size_t)(kbase + sr) * INC + C_VB + hd * 128 + sc; const bf16_t* vg = vg_;
    const int vl0 = V_OFF + v_st_nat<4>(sr, sc), vl1 = V_OFF + v_st_nat<4>(32 + sr, sc);
    const int vb0 = (int)(uintptr_t)X.ldsg + V_OFF + v_rd_base(lane);
    const int ka0 = (int)(uintptr_t)X.ldsg + K_OFF + jh * KT_BYTES + hi * KCH + r32 * 16;
    bf16x8 ks0, ks1, vs0, vs1;
#define DF_SLOAD(t) do { ks0 = *(const bf16x8*)(kg); ks1 = *(const bf16x8*)(kg + 32 * INC); vs0 = *(const bf16x8*)(vg); vs1 = *(const bf16x8*)(vg + 32 * INC); kg += 64 * INC; vg += 64 * INC; } while (0)
#define DF_SWRITE(buf) do { *(LAS bf16x8*)(L + kl + (buf) * 2 * KT_BYTES) = ks0; *(LAS bf16x8*)(L + kl + (buf) * 2 * KT_BYTES + 512) = ks1; \
        *(LAS bf16x8*)(L + vl0 + (buf) * 16384) = vs0; *(LAS bf16x8*)(L + vl1 + (buf) * 16384) = vs1; } while (0)
    float l_reg = 0.f; f32x16 o[4] = {};
    u32x4 negm_w = {0u, 0u, 0u, 0u}; const u32x4 ones_w = {hi == 0 ? 0x3F80u : 0u, 0u, 0u, 0u};
    LAS unsigned* flagp = (LAS unsigned*)(L + WS_OFF) + 8 * 64;
    if (tid == 0) *flagp = 0u;
    DF_SLOAD(0); VM_WAIT(); DF_SWRITE(0);
    __syncthreads();
    { f32x16 p0, p1; qkt64(p0, p1, L + K_OFF + jh * KT_BYTES, qr, r32, hi);
      float pmax = p0[0];
#pragma unroll
      for (int r = 1; r < 16; ++r) pmax = fmaxf(pmax, p0[r]);
#pragma unroll
      for (int r = 0; r < 16; ++r) pmax = fmaxf(pmax, p1[r]);
      { auto rr = __builtin_amdgcn_permlane32_swap(__float_as_uint(pmax), __float_as_uint(pmax), false, false); pmax = fmaxf(__uint_as_float(rr[0]), __uint_as_float(rr[1])); }
      negm_w.x = hi == 0 ? f2bf(-pmax) : 0u; }
    const bf16x8 negm_f = __builtin_bit_cast(bf16x8, negm_w), ones_f = __builtin_bit_cast(bf16x8, ones_w);
#pragma unroll 1
    for (int t = 0; t < NT; ++t) {
        const int buf = t & 1;
        __syncthreads();
        if (t + 1 < NT) DF_SLOAD(t + 1);
        bf16x8 pa0, pa1, pa2, pa3;
        bf16x8 kf[8]; s16x4 vl[16], vh[16]; f32x16 p0, p1;
        { const int ka = ka0 + buf * 2 * KT_BYTES, vb = vb0 + buf * 16384;
#pragma unroll
          for (int i = 0; i < 8; ++i) asm volatile("ds_read_b128 %0, %1 offset:%2" : "=&v"(kf[i]) : "v"(ka), "i"((i >> 1) * 2 * KCH + (i & 1) * 512) : "memory");
#define DF_VRD(i) do { asm volatile("ds_read_b64_tr_b16 %0, %1 offset:%2" : "=&v"(vl[i]) : "v"(vb), "i"(((i) >> 2) * 512 + ((i) & 3) * 4096) : "memory"); \
                       asm volatile("ds_read_b64_tr_b16 %0, %1 offset:%2" : "=&v"(vh[i]) : "v"(vb), "i"(((i) >> 2) * 512 + ((i) & 3) * 4096 + 2048) : "memory"); } while (0)
#pragma unroll
          for (int i = 0; i < 7; ++i) DF_VRD(i);
          { bf16x8 on_ = ones_f; asm volatile("" : "+v"(on_));
            p0 = __builtin_amdgcn_mfma_f32_32x32x16_bf16(on_, negm_f, (f32x16){}, 0, 0, 0); asm volatile("" : "+v"(on_)); p1 = __builtin_amdgcn_mfma_f32_32x32x16_bf16(on_, negm_f, (f32x16){}, 0, 0, 0); }
          __builtin_amdgcn_sched_barrier(0);
          asm volatile("s_waitcnt lgkmcnt(14)" ::: "memory"); __builtin_amdgcn_sched_barrier(0);
#pragma unroll
          for (int d0 = 0; d0 < 4; ++d0) { p0 = __builtin_amdgcn_mfma_f32_32x32x16_bf16(kf[2 * d0], qr[d0], p0, 0, 0, 0); p1 = __builtin_amdgcn_mfma_f32_32x32x16_bf16(kf[2 * d0 + 1], qr[d0], p1, 0, 0, 0); }
#pragma unroll
          for (int i = 7; i < 16; ++i) DF_VRD(i);
#undef DF_VRD
        }
        { float sa = 0.f, sb = 0.f, sc_ = 0.f, sd = 0.f;
#pragma unroll
          for (int r = 0; r < 16; r += 2) { p0[r] = __builtin_amdgcn_exp2f(p0[r]); p0[r + 1] = __builtin_amdgcn_exp2f(p0[r + 1]); sa += p0[r]; sb += p0[r + 1]; }
#pragma unroll
          for (int r = 0; r < 16; r += 2) { p1[r] = __builtin_amdgcn_exp2f(p1[r]); p1[r + 1] = __builtin_amdgcn_exp2f(p1[r + 1]); sc_ += p1[r]; sd += p1[r + 1]; }
          l_reg += (sa + sb) + (sc_ + sd); asm volatile("" : "+v"(l_reg)); }
#define ATT_PKN(P, BASE, OUT) do { u32x4 w; w.x = cvt_pk_bf16(P[BASE + 0], P[BASE + 1]); w.y = cvt_pk_bf16(P[BASE + 2], P[BASE + 3]); w.z = cvt_pk_bf16(P[BASE + 4], P[BASE + 5]); w.w = cvt_pk_bf16(P[BASE + 6], P[BASE + 7]); \
    OUT = __builtin_bit_cast(bf16x8, w); } while (0)
        ATT_PKN(p0, 0, pa0); ATT_PKN(p0, 8, pa1); ATT_PKN(p1, 0, pa2); ATT_PKN(p1, 8, pa3);
#undef ATT_PKN
        asm volatile("s_waitcnt lgkmcnt(0)" ::: "memory"); __builtin_amdgcn_sched_barrier(0);
#define DF_PK(i) (bf16x8){vl[i][0], vl[i][1], vl[i][2], vl[i][3], vh[i][0], vh[i][1], vh[i][2], vh[i][3]}
#pragma unroll
        for (int d0 = 0; d0 < 4; ++d0) {
            o[d0] = __builtin_amdgcn_mfma_f32_32x32x16_bf16(pa0, DF_PK(d0 * 4 + 0), o[d0], 0, 0, 0); o[d0] = __builtin_amdgcn_mfma_f32_32x32x16_bf16(pa1, DF_PK(d0 * 4 + 1), o[d0], 0, 0, 0);
            o[d0] = __builtin_amdgcn_mfma_f32_32x32x16_bf16(pa2, DF_PK(d0 * 4 + 2), o[d0], 0, 0, 0); o[d0] = __builtin_amdgcn_mfma_f32_32x32x16_bf16(pa3, DF_PK(d0 * 4 + 3), o[d0], 0, 0, 0); }
#undef DF_PK
        if (t + 1 < NT) { VM_WAIT(); DF_SWRITE(buf ^ 1); }
    }
#undef DF_SLOAD
#undef DF_SWRITE
    { auto rr = __builtin_amdgcn_permlane32_swap(__float_as_uint(l_reg), __float_as_uint(l_reg), false, false); l_reg = __uint_as_float(rr[0]) + __uint_as_float(rr[1]); }
    if (__any(!(l_reg < 1.0e30f)) && lane == 0) *flagp = 1u;
    if (hi == 0) wsf[32 + r32] = l_reg; LDS_WAIT();
    float rli[16];
#pragma unroll
    for (int r = 0; r < 16; ++r) rli[r] = __builtin_amdgcn_rcpf(wsf[32 + crow(r, hi)]);
#pragma unroll
    for (int d = 0; d < 4; ++d)
#pragma unroll
        for (int r = 0; r < 16; ++r) o[d][r] *= rli[r];
    __syncthreads();
    const bool redo = *flagp != 0u;
    LAS float* XO = (LAS float*)L + qsub * 4096;
    if (jh == 1) {
#pragma unroll
        for (int d = 0; d < 4; ++d)
#pragma unroll
            for (int r = 0; r < 16; ++r) XO[crow(r, hi) * 128 + d * 32 + r32] = o[d][r];
    }
    __syncthreads();
    if (jh == 0) {
        float ss[16];
#pragma unroll
        for (int r = 0; r < 16; ++r) { float s = 0.f;
#pragma unroll
            for (int d = 0; d < 4; ++d) { const float v = o[d][r] - lam * XO[crow(r, hi) * 128 + d * 32 + r32]; o[d][r] = v; s += v * v; }
            ss[r] = s; }
#pragma unroll
        for (int r = 0; r < 16; ++r) {
#pragma unroll
            for (int off = 1; off < 32; off <<= 1) ss[r] += __shfl_xor(ss[r], off);
            ss[r] = oscale / sqrtf(ss[r] * (1.f / 128.f) + EPS); }
        const int orow0 = (CTXQ ? NLAT + b * CTXL : b * SEQ) + qblk * 128 + qsub * 32;
#pragma unroll
        for (int d = 0; d < 4; ++d) { const float g = gain[d * 32 + r32];
#pragma unroll
            for (int r = 0; r < 16; ++r) CAT[(size_t)(orow0 + crow(r, hi)) * D + 256 + hd * 128 + d * 32 + r32] = (bf16_t)f2bf(o[d][r] * ss[r] * g); }
    }
    __syncthreads();
    if (redo) diff_unit_safe<CTXQ>(X0, QKV, CAT, b, hd, qblk, lam, gain, oscale);
}

template <bool CTXQ>
__device__ __forceinline__ void na_unit(const Ctx& X0, const bf16_t* QKV, bf16_t* CAT, const float* rpb  , int b, int h, int r0) {
    const Ctx X = fresh(X0);
    constexpr int K_OFF = 0, V_OFF = 16896, RPB_OFF = V_OFF + 2 * 8192  , WS_OFF = RPB_OFF + 2048;
    const int tid = X.tid, lane = X.lane, wid = X.wave, r32 = lane & 31, hi = lane >> 5;
    LAS char* L = (LAS char*)X.lds;
    LAS float* wsf = (LAS float*)(L + WS_OFF) + wid * 64;
    LAS float* rpbL = (LAS float*)(L + RPB_OFF);
    const int kbase = b * KVR;
    int kr_lo = 0, nlat = 0, r = 0, qc = 0, rs = 0, qrow, orow;
    if (CTXQ) { qrow = kbase + wid * 32 + r32; orow = NLAT + b * CTXL + wid * 32; }
    else {
        kr_lo = min(max(r0 - 4, 0), GROWS - 8); const int kr_hi = min(max(r0 + 3 - 4, 0), GROWS - 8) + 8; nlat = kr_hi - kr_lo;
        r = r0 + (wid >> 1); qc = 32 * (wid & 1) + r32; rs = min(max(r - 4, 0), GROWS - 8);
        qrow = kbase + CTXL + r * GRIDW + qc; orow = b * SEQ + r * GRIDW + 32 * (wid & 1);
        for (int i = tid; i < 15 * 31; i += NWAVES * 64) rpbL[i] = rpb[i] * LOG2E;
    }
    const int NT = nlat + CTXL / 64;
    bf16x8 qr[4];
#pragma unroll
    for (int d0 = 0; d0 < 4; ++d0) qr[d0] = *(const bf16x8*)(QKV + (size_t)qrow * INC + C_QA + h * 64 + d0 * 16 + hi * 8);
    const int srow = tid >> 3, sc8 = tid & 7;
    const bf16_t* kg = QKV + (size_t)kbase * INC + C_KA + h * 64 + sc8 * 8;
    const bf16_t* vg = QKV + (size_t)kbase * INC + C_VA + h * 64 + sc8 * 8;
    const int kl = K_OFF + sc8 * KCH + srow * 16, vl = V_OFF + v_st<2>(srow, sc8 * 8);
    const int vb0 = (int)(uintptr_t)X.ldsg + V_OFF + v_rd_base(lane);
    bf16x8 ksA, vsA, ksB, vsB;
#define NA_TROW(t) ((t) < nlat ? CTXL + (kr_lo + (t)) * GRIDW : ((t) - nlat) * 64)
#define NA_SLOAD(S, t) do { const int tt_ = (t) < NT ? (t) : NT - 1; const size_t go = (size_t)(NA_TROW(tt_) + srow) * INC; ks##S = *(const bf16x8*)(kg + go); vs##S = *(const bf16x8*)(vg + go); } while (0)
#define NA_SWRITE(S, buf) do { *(LAS bf16x8*)(L + kl + (buf) * KT_BYTES) = ks##S; *(LAS bf16x8*)(L + vl + (buf) * 8192) = vs##S; } while (0)
    float m_reg = -1e30f, l_reg = 0.f; f32x16 o[2] = {};
    const int ws = min(max(qc - 8, 0), GRIDW - 16);
#define NA_STEP(t_, buf_) do { const int tq_ = (t_); \
        const bool lat_tile = tq_ < nlat; \
        const int drow = kr_lo + tq_ - r + 7; \
        const bool active = !lat_tile || (unsigned)(kr_lo + tq_ - rs) < 8u; \
        if (active) { \
            f32x16 p0, p1; float alpha; bf16x8 pa0, pa1, pa2, pa3; \
            qkt64(p0, p1, L + K_OFF + (buf_) * KT_BYTES, qr, r32, hi); \
            if (lat_tile) { \
                const LAS float* bp = rpbL + drow * 31 + 15 - qc; \
                _Pragma("unroll") for (int rr = 0; rr < 16; ++rr) { const int k0 = crow(rr, hi), k1 = k0 + 32; \
                    const bool v0 = (unsigned)(k0 - ws) < 16u, v1 = (unsigned)(k1 - ws) < 16u; \
                    const float b0 = bp[v0 ? k0 : qc], b1 = bp[v1 ? k1 : qc]; \
                    p0[rr] = v0 ? p0[rr] + b0 : -1e30f; p1[rr] = v1 ? p1[rr] + b1 : -1e30f; } \
            } \
            softmax_tile(p0, p1, m_reg, l_reg, alpha, pa0, pa1, pa2, pa3); \
            if (__any(alpha < 1.f)) { if (hi == 0) wsf[r32] = alpha; LDS_WAIT(); \
                _Pragma("unroll") for (int d = 0; d < 2; ++d) \
                    _Pragma("unroll") for (int rr = 0; rr < 16; ++rr) o[d][rr] *= wsf[crow(rr, hi)]; } \
            const int vb = vb0 + (buf_) * 8192; \
            pv_one<0, 2>(o[0], vb, pa0, pa1, pa2, pa3); pv_one<1, 2>(o[1], vb, pa0, pa1, pa2, pa3); \
        } } while (0)
    NA_SLOAD(A, 0); NA_SLOAD(B, 1); NA_SWRITE(A, 0);
    for (int t = 0; t < NT; t += 2) {
        __syncthreads();
        NA_SLOAD(A, t + 2);
        NA_STEP(t, 0);
        NA_SWRITE(B, 1);
        if (t + 1 < NT) {
            __syncthreads();
            NA_SLOAD(B, t + 3);
            NA_STEP(t + 1, 1);
            NA_SWRITE(A, 0);
        }
    }
#undef NA_STEP
#undef NA_TROW
#undef NA_SLOAD
#undef NA_SWRITE
    if (hi == 0) wsf[32 + r32] = l_reg; LDS_WAIT();
#pragma unroll
    for (int rr = 0; rr < 16; ++rr) { const float rl = __builtin_amdgcn_rcpf(wsf[32 + crow(rr, hi)]);
#pragma unroll
        for (int d = 0; d < 2; ++d) CAT[(size_t)(orow + crow(rr, hi)) * D + h * 64 + d * 32 + r32] = (bf16_t)f2bf(o[d][rr] * rl); }
    __syncthreads();
}
}

__device__ __forceinline__ void moe_route_phase(const Ctx& X0, const float* xlat, const float* shift0, const float* scale0, const float* router_w, unsigned char* H8) {
    const Ctx X = fresh(X0);
    LAS float* WrT = (LAS float*)X.lds;
    LAS int* pe = (LAS int*)(X.lds + 32768);
    LAS int* psl = pe + 512;
    LAS int* lcnt = psl + 512;
    LAS int* gbase = lcnt + 8;
    int* tokl = (int*)(X.ws + WS_TOKL); unsigned* tinfo = (unsigned*)(X.ws + WS_TINFO);
    for (int i = X.tid; i < D * NEXP; i += NWAVES * 64) WrT[(i & 7) * D + (i >> 3)] = router_w[i];
    if (X.tid < 8) lcnt[X.tid] = 0;
    __syncthreads();
    const int gw = X.vcu * NWAVES + X.wave, NGW = X.G * NWAVES;
    int nr = 0;
    for (int m = gw; m < NLAT && nr < 32; m += NGW, ++nr) {
        const int v = m < SEQ ? 0 : 1;
        const GAS f32x4* xr = (const GAS f32x4*)(xlat + (size_t)m * D) + X.lane;
        const f32x4* shp = (const f32x4*)(shift0 + (size_t)v * 6 * D) + X.lane; const f32x4* scp = (const f32x4*)(scale0 + (size_t)v * 6 * D) + X.lane;
        f32x4 xv[4]; float s2 = 0.f;
#pragma unroll
        for (int j = 0; j < 4; ++j) { xv[j] = xr[64 * j]; s2 += (xv[j].x * xv[j].x + xv[j].y * xv[j].y) + (xv[j].z * xv[j].z + xv[j].w * xv[j].w); }
        const float rstd = 1.f / sqrtf(wave_sum(s2) * (1.f / D) + EPS);
        GAS unsigned* o4 = (GAS unsigned*)(H8 + (size_t)m * D) + X.lane;
        float lg[8];
#pragma unroll
        for (int e = 0; e < 8; ++e) lg[e] = 0.f;
#pragma unroll
        for (int j = 0; j < 4; ++j) { const f32x4 sh = shp[64 * j], sc = scp[64 * j]; const f32x4 h = xv[j] * rstd * (sc + 1.f) + sh;
            o4[64 * j] = pk_fp8x4(h.x, h.y, h.z, h.w);
#pragma unroll
            for (int e = 0; e < 8; ++e) { const f32x4 wr = *(const LAS f32x4*)(WrT + e * D + 256 * j + 4 * X.lane); lg[e] += (h.x * wr.x + h.y * wr.y) + (h.z * wr.z + h.w * wr.w); } }
#pragma unroll
        for (int e = 0; e < 8; ++e) lg[e] = wave_sum(lg[e]);
        int i1 = 0; float v1 = lg[0];
#pragma unroll
        for (int e = 1; e < 8; ++e) if (lg[e] > v1) { v1 = lg[e]; i1 = e; }
        int i2 = -1; float v2 = -3.0e38f;
#pragma unroll
        for (int e = 0; e < 8; ++e) if (e != i1 && lg[e] > v2) { v2 = lg[e]; i2 = e; }
        const float g1 = 1.f / (1.f + __expf(v2 - v1)), g2 = 1.f - g1;
        if (X.lane == 0) {
            const int s1 = __hip_atomic_fetch_add(lcnt + i1, 1, __ATOMIC_RELAXED, __HIP_MEMORY_SCOPE_WORKGROUP);
            const int s2_ = __hip_atomic_fetch_add(lcnt + i2, 1, __ATOMIC_RELAXED, __HIP_MEMORY_SCOPE_WORKGROUP);
            const int pi = (X.wave * 32 + nr) * 2; pe[pi] = i1; pe[pi + 1] = i2; psl[pi] = s1; psl[pi + 1] = s2_;
            unsigned* ti = tinfo + (size_t)m * 8; ti[4] = __float_as_uint(g1); ti[5] = __float_as_uint(g2);
        }
    }
    __syncthreads();
    if (X.tid < 8) gbase[X.tid] = (int)__hip_atomic_fetch_add((unsigned*)(X.ctl + CW_ECNT + 64 * X.tid), (unsigned)lcnt[X.tid], RLX_AGENT);
    __syncthreads();
    if (X.lane < 2 * nr) {
        const int i = X.lane >> 1, k = X.lane & 1, pi = (X.wave * 32 + i) * 2 + k, m = gw + i * NGW;
        const int e = pe[pi], slot = gbase[e] + psl[pi];
        tokl[e * 16384 + slot] = m;
        unsigned* ti = tinfo + (size_t)m * 8; ti[2 * k] = (unsigned)e; ti[2 * k + 1] = (unsigned)slot;
    }
    __syncthreads();
}
__device__ __forceinline__ int moe_setup(const Ctx& X0) {
    const Ctx X = fresh(X0);
    if (X.tid == 0) { unsigned pre = 0;
        for (int e = 0; e < NEXP; ++e) { unsigned c = __hip_atomic_load((unsigned*)(X.ctl + CW_ECNT + 64 * e), RLX_AGENT); if (c > 16384u) c = 16384u; X.MISC[16 + e] = pre; X.MISC[32 + e] = c; pre += (c + 255u) >> 8; }
        X.MISC[16 + NEXP] = pre > (unsigned)MOE_MAXP ? (unsigned)MOE_MAXP : pre; }
    __syncthreads();
    return (int)X.MISC[16 + NEXP];
}
__device__ __forceinline__ void final_phase(const Ctx& X0, float* xlat, const bf16_t* Y, const float* gf0, const float* fgain) {
    const Ctx X = fresh(X0);
    const unsigned* tinfo = (const unsigned*)(X.ws + WS_TINFO);
    const int gw = X.vcu * NWAVES + X.wave, NGW = X.G * NWAVES;
    for (int m = gw; m < NLAT; m += NGW) {
        const int v = m < SEQ ? 0 : 1;
        const unsigned* ti = tinfo + (size_t)m * 8;
        const int e1 = (int)ti[0], s1 = (int)ti[1], e2 = (int)ti[2], s2 = (int)ti[3]; const float g1 = __uint_as_float(ti[4]), g2 = __uint_as_float(ti[5]);
        const size_t y1 = (size_t)((int)X.MISC[16 + e1] * 256 + s1), y2 = (size_t)((int)X.MISC[16 + e2] * 256 + s2);
        GAS f32x4* xr = (GAS f32x4*)(xlat + (size_t)m * D) + X.lane;
        const bf16_t* Yt = (const bf16_t*)(X.ws + WS_YT);
        f32x4 ya[4], yb[4];
        if (y1 < 32768) {
#pragma unroll
            for (int j = 0; j < 4; ++j) { const u32x2 w = ((const u32x2*)(Y + y1 * D) + X.lane)[64 * j]; ya[j] = (f32x4){__uint_as_float(w.x << 16), __uint_as_float(w.x & 0xffff0000u), __uint_as_float(w.y << 16), __uint_as_float(w.y & 0xffff0000u)}; }
        } else {
#pragma unroll
            for (int j = 0; j < 4; ++j) { ya[j] = (f32x4){0.f, 0.f, 0.f, 0.f};
#pragma unroll
                for (int sl = 0; sl < 7; ++sl) { const u32x2 w = ((const u32x2*)(Yt + ((size_t)sl * 2048 + (y1 - 32768)) * D) + X.lane)[64 * j];
                    ya[j] += (f32x4){__uint_as_float(w.x << 16), __uint_as_float(w.x & 0xffff0000u), __uint_as_float(w.y << 16), __uint_as_float(w.y & 0xffff0000u)}; } }
        }
        if (y2 < 32768) {
#pragma unroll
            for (int j = 0; j < 4; ++j) { const u32x2 w = ((const u32x2*)(Y + y2 * D) + X.lane)[64 * j]; yb[j] = (f32x4){__uint_as_float(w.x << 16), __uint_as_float(w.x & 0xffff0000u), __uint_as_float(w.y << 16), __uint_as_float(w.y & 0xffff0000u)}; }
        } else {
#pragma unroll
            for (int j = 0; j < 4; ++j) { yb[j] = (f32x4){0.f, 0.f, 0.f, 0.f};
#pragma unroll
                for (int sl = 0; sl < 7; ++sl) { const u32x2 w = ((const u32x2*)(Yt + ((size_t)sl * 2048 + (y2 - 32768)) * D) + X.lane)[64 * j];
                    yb[j] += (f32x4){__uint_as_float(w.x << 16), __uint_as_float(w.x & 0xffff0000u), __uint_as_float(w.y << 16), __uint_as_float(w.y & 0xffff0000u)}; } }
        }
        const f32x4* gp = (const f32x4*)(gf0 + (size_t)v * 6 * D) + X.lane; const f32x4* fg = (const f32x4*)fgain + X.lane;
        f32x4 xv[4]; float ss = 0.f;
#pragma unroll
        for (int j = 0; j < 4; ++j) { xv[j] = xr[64 * j] + gp[64 * j] * (ya[j] * g1 + yb[j] * g2); ss += (xv[j].x * xv[j].x + xv[j].y * xv[j].y) + (xv[j].z * xv[j].z + xv[j].w * xv[j].w); }
        const float rstd = 1.f / sqrtf(wave_sum(ss) * (1.f / D) + EPS);
#pragma unroll
        for (int j = 0; j < 4; ++j) xr[64 * j] = xv[j] * rstd * fg[64 * j];
    }
}

constexpr int N_PHASES = 16;
constexpr int N_LAUNCHES = MK_N_LAUNCHES;
__global__ void __launch_bounds__(NWAVES * 64, 2) fwd(Params P) {
    extern __shared__ __attribute__((aligned(16))) unsigned char lds[];
    Ctx X;
    X.lds = (LAS unsigned char*)lds; X.ldsg = (char*)lds;
    X.MISC = (volatile LAS unsigned*)(X.lds + MISC_OFF);
    X.tid = threadIdx.x; X.lane = X.tid & 63; X.wave = __builtin_amdgcn_readfirstlane(X.tid >> 6);
    X.G = gridDim.x; { const int bx = blockIdx.x; X.vcu = (X.G % 8 == 0) ? (bx % 8) * (X.G / 8) + bx / 8 : bx; }
    X.ws = P.ws; X.ctl = (gu32*)(P.ws + WS_CTL);
    for (int u = X.tid; u < (LDS_BYTES - RING_BYTES) / 4; u += NWAVES * 64) ((LAS unsigned*)(X.lds + RING_BYTES))[u] = 0u;
    __syncthreads();
    XcdBarrier bar; bar.bar = (unsigned*)(X.ctl + CW_BAR); bar.x = 0; bar.st = nullptr;
    if (N_LAUNCHES != N_PHASES) bar = xcd_barrier_post((unsigned*)(X.ctl + CW_BAR), X.MISC + 8);
#define GRID_BAR() do { if (N_LAUNCHES == N_PHASES) { if (X.tid == 0) __hip_atomic_store(X.ctl + CW_TMO, 0xBADBA0u, RLX_AGENT); } else { xcd_barrier(bar); } } while (0)
    const int lo = P.ph_lo, hi = P.ph_hi;
#ifndef PH_MASK
#define PH_MASK 0xFFFF
#endif
#define IN(k) (((PH_MASK >> (k)) & 1) && lo <= (k) && (k) < hi)
#ifndef REP_MASK
#define REP_MASK 0
#endif
#define REPS(k) (((REP_MASK >> (k)) & 1) ? 2 : 1)
#define BOTH(k) (IN(k) && IN((k) + 1))
#define LIN(j) (((PH_MASK >> (1 + (j))) & 1) && lo <= (pb + (j)) && (pb + (j)) < hi)
#define LBOTH(j) (LIN(j) && lo <= (pb + (j) + 1) && (pb + (j) + 1) < hi)
    unsigned char* ws = P.ws;
    bf16_t* H = (bf16_t*)(ws + WS_H); bf16_t* QKV = (bf16_t*)(ws + WS_QKV); bf16_t* CAT = (bf16_t*)(ws + WS_CAT); bf16_t* HID = (bf16_t*)(ws + WS_HID);
    float* XCTX = (float*)(ws + WS_XCTX);

    if (IN(0)) { for (int rep = 0; rep < REPS(0); ++rep) { p0_prologue(X, P); if (rep + 1 < REPS(0)) GRID_BAR(); } if (BOTH(0)) GRID_BAR(); }

    for (int Lr = 0; Lr < 2; ++Lr) {
        const int L = __builtin_amdgcn_readfirstlane(Lr);
        const int pb = 1 + 7 * L;
        const float* xl = L == 0 ? P.x : P.out; const float* xc = L == 0 ? P.ctx : XCTX;
        if (LIN(0)) { norm_phase(X, xl, xc, modp(X, L, 0, 0), modp(X, L, 0, 1), H, MROWS, L == 1 ? (const float*)(ws + WS_CAT) : nullptr, modp(X, 0, 2, 5)); if (LBOTH(0)) GRID_BAR(); }
        if (LIN(1)) {
            SchedPlain S; S.T.init(NLAT / 256, INC / 256, X.G, (int)blockIdx.x); S.Bt = (const char*)(ws + WS_WIN) + (size_t)L * INC * D * 2; S.K = D;
            EpiInProj E{QKV, (const f32x2*)(ws + WS_TABR), (const f32x2*)(ws + WS_TABC)};
            { const int co = L == 0 ? 0 : C_KA;
              thin_gemm(X, H + (size_t)NLAT * D, (const bf16_t*)(ws + WS_WIN) + (size_t)L * INC * D + (size_t)co * D, L == 0 ? INC : C_XIN - C_KA, D, ThinInProj{QKV, co}, X.vcu, X.G); }
            for (int rep = 0; rep < REPS(2); ++rep) { pg8::gemm_phase<EpiInProj, SchedPlain, true>(X.lds, (const char*)H, D, S, E); if (rep + 1 < REPS(2)) GRID_BAR(); }
            if (LBOTH(1)) GRID_BAR();
        }
        if (LIN(2)) {
            for (int rep = 0; rep < REPS(3); ++rep) {
            const float lam = ((const float*)(ws + WS_LAM))[L]; const float oscale = L == 0 ? 0.8f : (1.f - (0.8f - 0.6f * 0.74081822068171786607f));
            const float* gain = P.diff_subln + L * 128;
            for (int u = X.vcu; u < 512; u += X.G) { const int bh = (u & 255) >> 5, qblk = (u & 31) + 32 * (u >> 8); att::diff_unit_fast<false>(X, QKV, CAT, bh >> 2, bh & 3, qblk, lam, gain, oscale); }
            for (int u = X.vcu; u < 256; u += X.G) { const int b = u >> 7, h = (u >> 5) & 3, r0 = (u & 31) * 4; att::na_unit<false>(X, QKV, CAT, P.na_rpb + (L * 4 + h) * 465, b, h, r0); }
            if (L == 0) {
                for (int u = X.vcu; u < 16; u += X.G) att::diff_unit_fast<true>(X, QKV, CAT, u >> 3, (u >> 1) & 3, u & 1, lam, gain, oscale);
                for (int u = X.vcu - 16; u < 8; u += X.G) if (u >= 0) att::na_unit<true>(X, QKV, CAT, nullptr, u >> 2, u & 3, 0);
            }
            conv_phase(X, QKV, CAT, P.conv_w + L * 768, L == 0 ? MROWS : NLAT, (L == 0 && X.G > 48) ? 24 : 0);
            if (rep + 1 < REPS(3)) GRID_BAR(); }
            if (LBOTH(2)) GRID_BAR();
        }
        if (LIN(3)) {
            SchedPlain S; S.T.init(NLAT / 256, D / 256, X.G, (int)blockIdx.x); S.Bt = (const char*)(ws + WS_WOUT) + (size_t)L * D * D * 2; S.K = D;
            EpiResGate E{xl, xc, P.out, XCTX, modp(X, L, 0, 2)};
            if (L == 0) thin_gemm(X, CAT + (size_t)NLAT * D, (const bf16_t*)(ws + WS_WOUT), D, D, ThinPartial{(float*)(ws + WS_HID)}, X.vcu, X.G, 2);
            pg8::gemm_phase<EpiResGate, SchedPlain, true>(X.lds, (const char*)CAT, D, S, E);
            if (LBOTH(3)) GRID_BAR();
        }
        if (L == 0) {
            if (IN(5)) { norm_phase(X, P.out, P.ctx, modp(X, 0, 0, 3), modp(X, 0, 0, 4), H, MROWS, (const float*)(ws + WS_HID), modp(X, 0, 2, 2), XCTX); if (BOTH(5)) GRID_BAR(); }
            if (IN(6)) {
                SchedPlain S; S.T.init(NLAT / 256, 2 * DFF / 256, X.G, (int)blockIdx.x); S.Bt = (const char*)(ws + WS_W13); S.K = D;
                EpiSwiGLU E{HID, DFF};
                for (int rep = 0; rep < REPS(6); ++rep) { pg8::gemm_phase<EpiSwiGLU, SchedPlain, true>(X.lds, (const char*)H, D, S, E); if (rep + 1 < REPS(6)) GRID_BAR(); }
                { const int nun = (NLAT / 256) * (2 * DFF / 256), nshort = X.G - nun % X.G, b0 = (int)blockIdx.x - nun % X.G;
                  if (nun % X.G == 0) thin_gemm(X, H + (size_t)NLAT * D, (const bf16_t*)(ws + WS_W13), 2 * DFF, D, ThinSwiGLU{HID + (size_t)NLAT * DFF, DFF}, X.vcu, X.G);
                  else if (b0 >= 0) thin_gemm(X, H + (size_t)NLAT * D, (const bf16_t*)(ws + WS_W13), 2 * DFF, D, ThinSwiGLU{HID + (size_t)NLAT * DFF, DFF}, nun % X.G + b0, nshort);
                  else thin_gemm(X, H + (size_t)NLAT * D, (const bf16_t*)(ws + WS_W13), 2 * DFF, D, ThinSwiGLU{HID + (size_t)NLAT * DFF, DFF}, (int)blockIdx.x, 1 << 24); }
                if (BOTH(6)) GRID_BAR();
            }
            if (IN(7)) {
                SchedPlain S; S.T.init(NLAT / 256, D / 256, X.G, (int)blockIdx.x); S.Bt = (const char*)(ws + WS_W2); S.K = DFF;
                EpiResGate E{P.out, XCTX, P.out, XCTX, modp(X, 0, 0, 5)};
                thin_gemm(X, HID + (size_t)NLAT * DFF, (const bf16_t*)(ws + WS_W2), D, DFF, ThinPartial{(float*)(ws + WS_CAT)}, X.vcu, X.G, 2);
                pg8::gemm_phase<EpiResGate, SchedPlain, true>(X.lds, (const char*)HID, DFF, S, E);
                if (BOTH(7)) GRID_BAR();
            }
        }
    }
    if (IN(12)) { moe_route_phase(X, P.out, modp(X, 1, 0, 3), modp(X, 1, 0, 4), P.router_w, (unsigned char*)H); if (BOTH(12)) GRID_BAR(); }
    if (IN(13)) {
        const int NP = moe_setup(X);
        SchedMoe<true> S; S.T.init(NP, 2 * DEXP / 256, X.G, (int)blockIdx.x); S.Bt = (const char*)(ws + WS_MW13); S.K = D / 2; S.estride = (size_t)2 * DEXP * D; S.M = X.MISC; S.tokl = (const int*)(ws + WS_TOKL); S.q = X.ctl + CW_MOEQ; { const int rounds = S.T.nwg / X.G; S.Rs = rounds > 2 ? rounds - 1 : 1; } if (X.tid == 0) X.MISC[51] = 0u;
        EpiSwiGLU8 E{ws + WS_MHID, DEXP};
        for (int rep = 0; rep < REPS(13); ++rep) { pg8::gemm_phase<EpiSwiGLU8, SchedMoe<true>, true, true>(X.lds, (const char*)H, D / 2, S, E); if (rep + 1 < REPS(13)) GRID_BAR(); }
        if (BOTH(13)) GRID_BAR();
    }
    if (IN(14)) {
        const int NP = moe_setup(X);
        SchedMoe<false> S; S.T.init(NP < 128 ? NP : 128, D / 256, X.G, (int)blockIdx.x); S.q = X.ctl + CW_MOEQ; S.Rs = 1 << 20; S.Bt = (const char*)(ws + WS_MW2); S.K = DEXP / 2; S.estride = (size_t)D * DEXP; S.M = X.MISC; S.tokl = nullptr;
        EpiStoreBf16 E{(bf16_t*)(ws + WS_Y), 1.f / MOE_W2_SCALE};
        for (int rep = 0; rep < REPS(14); ++rep) { pg8::gemm_phase<EpiStoreBf16, SchedMoe<false>, true, true>(X.lds, (const char*)(ws + WS_MHID), DEXP / 2, S, E); if (rep + 1 < REPS(14)) GRID_BAR(); }
        if (NP > 128) {
            SchedMoeTail St; St.first = (int)blockIdx.x; St.count = (NP - 128) * 4 * 7; St.Bt = (const char*)(ws + WS_MW2); St.K = DEXP / 2; St.estride = (size_t)D * DEXP; St.M = X.MISC;
            EpiTailPart Et{(bf16_t*)(ws + WS_YT), 1.f / MOE_W2_SCALE};
            pg8::gemm_phase<EpiTailPart, SchedMoeTail, true, true>(X.lds, (const char*)(ws + WS_MHID), DEXP / 2, St, Et, 256);
        }
        if (BOTH(14)) GRID_BAR();
    }
    if (IN(15)) { (void)moe_setup(X); final_phase(X, P.out, (const bf16_t*)(ws + WS_Y), modp(X, 1, 0, 5), P.final_gain); }
#undef IN
#undef LIN
#undef LBOTH
#undef BOTH
#undef GRID_BAR
}

extern "C" void kernel_launch(void* const* d_in, const int* in_sizes, int n_in, void* d_out, int out_size, void* d_ws, size_t ws_size, hipStream_t stream) {
    static int grid = 0;
    if (grid == 0) {
        if (n_in != 20 || in_sizes[0] != NLAT * D || out_size != NLAT * D || ws_size < WS_END) { fprintf(stderr, "kernel_launch: unexpected shapes (n_in %d, in0 %d, out %d, ws %zu < %zu)\n", n_in, n_in > 0 ? in_sizes[0] : -1, out_size, ws_size, (size_t)WS_END); grid = -1; return; }
        int dev = 0, cus = 0, per_cu = 0;
        if (hipGetDevice(&dev) != hipSuccess || hipDeviceGetAttribute(&cus, hipDeviceAttributeMultiprocessorCount, dev) != hipSuccess) { grid = -1; return; }
        if (hipFuncSetAttribute((const void*)fwd, hipFuncAttributeMaxDynamicSharedMemorySize, LDS_BYTES) != hipSuccess) { fprintf(stderr, "kernel_launch: hipFuncSetAttribute failed\n"); grid = -1; return; }
        if (hipOccupancyMaxActiveBlocksPerMultiprocessor(&per_cu, (const void*)fwd, NWAVES * 64, LDS_BYTES) != hipSuccess || per_cu < 1) { fprintf(stderr, "kernel_launch: occupancy query says %d blocks per CU\n", per_cu); }
        (void)hipGetLastError();
        grid = cus;
    }
    if (grid < 0) return;
    if (hipMemsetAsync((char*)d_ws + WS_CTL, 0, CTL_ZERO_BYTES, stream) != hipSuccess) return;
    Params p{};
    const float** pp = (const float**)&p;
    for (int i = 0; i < 20; ++i) pp[i] = (const float*)d_in[i];
    p.out = (float*)d_out; p.ws = (unsigned char*)d_ws;
    for (int li = 0; li < N_LAUNCHES; ++li) {
        p.ph_lo = (N_LAUNCHES == N_PHASES) ? li : 0; p.ph_hi = (N_LAUNCHES == N_PHASES) ? li + 1 : N_PHASES; p.li = li; p.pad = 0;
        hipLaunchKernelGGL(fwd, dim3(grid), dim3(NWAVES * 64), LDS_BYTES, stream, p);
    }
}
```
